# Optimizing an MI355X kernel written in HIP

```python
import math
import jax, jax.numpy as jnp
from jax import lax
import numpy as np

D_MODEL = 1024
BATCH = 8
SEQ = 8192
DEPTH = 1
DEC_BATCH = 8
DEC_SEQ = 64
PAST_LEN = 2048

CHUNK = 64
D_MIX = D_MODEL
SSM_WIDTH = D_MIX // 2
SSM_GROUP = 16
SSM_GROUPS = SSM_WIDTH // SSM_GROUP
SSM_STATE = 64
SSM_BLOCK = 128
ATTN_WIDTH = D_MIX - SSM_WIDTH
HEAD_DIM = 64
N_HEADS = ATTN_WIDTH // HEAD_DIM
Q_BLOCK = 128
ATTN_SCALE = HEAD_DIM ** -0.5
NORM_EPS = 1e-6
IN_WIDTH = 2 * SSM_WIDTH + 4 * ATTN_WIDTH + N_HEADS
IN_SPLITS = [SSM_WIDTH, 2 * SSM_WIDTH, 2 * SSM_WIDTH + ATTN_WIDTH, 2 * SSM_WIDTH + 2 * ATTN_WIDTH,
             2 * SSM_WIDTH + 3 * ATTN_WIDTH, 2 * SSM_WIDTH + 4 * ATTN_WIDTH]

kernel_name = 'hymba_s5_fox_stream_step'


def _rmsnorm(x, g):
    xf = x.astype(jnp.float32)
    y = xf * lax.rsqrt(jnp.mean(xf * xf, axis=-1, keepdims=True) + NORM_EPS)
    return (y * g.astype(jnp.float32)).astype(x.dtype)


def _zoh(log_dt, a_re, a_im, b_re, b_im):
    f32 = jnp.float32
    dt = jnp.exp(log_dt.astype(f32))[:, None]
    a_re = a_re.astype(f32)
    a_im = a_im.astype(f32)
    mag = jnp.exp(a_re * dt)
    ang = a_im * dt
    abar_re = mag * jnp.cos(ang)
    abar_im = mag * jnp.sin(ang)
    den = a_re * a_re + a_im * a_im
    n_re = abar_re - 1.0
    n_im = abar_im
    q_re = (n_re * a_re + n_im * a_im) / den
    q_im = (n_im * a_re - n_re * a_im) / den
    b_re = b_re.astype(f32)
    b_im = b_im.astype(f32)
    bbar_re = q_re[..., None] * b_re - q_im[..., None] * b_im
    bbar_im = q_re[..., None] * b_im + q_im[..., None] * b_re
    return abar_re, abar_im, bbar_re, bbar_im


def _complex_combine(e1, e2):
    a1r, a1i, b1r, b1i = e1
    a2r, a2i, b2r, b2i = e2
    return (a2r * a1r - a2i * a1i, a2r * a1i + a2i * a1r,
            a2r * b1r - a2i * b1i + b2r, a2r * b1i + a2i * b1r + b2i)


def _s5_segment(u, h_re, h_im, abar_re, abar_im, bbar_re, bbar_im, c_re, c_im, d_skip):
    bu_re = jnp.einsum('btgp,gnp->btgn', u, bbar_re)
    bu_im = jnp.einsum('btgp,gnp->btgn', u, bbar_im)
    bu_re = bu_re.at[:, 0].add(abar_re * h_re - abar_im * h_im)
    bu_im = bu_im.at[:, 0].add(abar_re * h_im + abar_im * h_re)
    a_re = jnp.broadcast_to(abar_re, bu_re.shape)
    a_im = jnp.broadcast_to(abar_im, bu_im.shape)
    _, _, x_re, x_im = lax.associative_scan(_complex_combine, (a_re, a_im, bu_re, bu_im), axis=1)
    y = (jnp.einsum('btgn,gpn->btgp', x_re, c_re) - jnp.einsum('btgn,gpn->btgp', x_im, c_im)
         + d_skip * u)
    return y, x_re[:, -1], x_im[:, -1]


def _fox_attend(q, cum_q, pos_q, k, v, cum_k, pos_k):
    s = jnp.einsum('bqhd,bkhd->bhqk', q, k).astype(jnp.float32) * ATTN_SCALE
    s = s + jnp.transpose(cum_q, (0, 2, 1))[:, :, :, None] - jnp.transpose(cum_k, (0, 2, 1))[:, :, None, :]
    mask = pos_k[None, :] <= pos_q[:, None]
    s = jnp.where(mask[None, None], s, -jnp.inf)
    p = jax.nn.softmax(s, axis=-1)
    return jnp.einsum('bhqk,bkhd->bqhd', p.astype(v.dtype), v)


def _layer(x, c, h_re, h_im, past, w_ada, b_ada, norm_g, w_in, b_f, q_norm_g, k_norm_g,
           ssm_log_dt, ssm_a_re, ssm_a_im, ssm_b_re, ssm_b_im, ssm_c_re, ssm_c_im, ssm_d,
           w_glu, b_glu, w_out):
    f32 = jnp.float32
    n_b, n_t, _ = x.shape
    mod = jax.nn.silu(c) @ w_ada + b_ada
    shift, scale, gate = jnp.split(mod, 3, axis=-1)
    h = _rmsnorm(x, norm_g) * (1.0 + scale[:, None, :]) + shift[:, None, :]
    proj = h @ w_in
    u, z_s, q, k, v, z_a, f_logit = jnp.split(proj, IN_SPLITS, axis=-1)

    abar_re, abar_im, bbar_re, bbar_im = _zoh(ssm_log_dt, ssm_a_re, ssm_a_im, ssm_b_re, ssm_b_im)
    c_re = ssm_c_re.astype(f32)
    c_im = ssm_c_im.astype(f32)
    d_skip = ssm_d.astype(f32)
    ug = u.astype(f32).reshape(n_b, n_t, SSM_GROUPS, SSM_GROUP)
    if h_re is None:
        n_blk = n_t // SSM_BLOCK
        ub = ug.reshape(n_b, n_blk, SSM_BLOCK, SSM_GROUPS, SSM_GROUP).transpose(1, 0, 2, 3, 4)
        h0 = jnp.zeros((n_b, SSM_GROUPS, SSM_STATE), f32)

        def step(carry, u_blk):
            y_blk, hr, hi = _s5_segment(u_blk, carry[0], carry[1], abar_re, abar_im,
                                        bbar_re, bbar_im, c_re, c_im, d_skip)
            return (hr, hi), y_blk

        (h_re_new, h_im_new), ys = lax.scan(step, (h0, h0), ub)
        y_ssm = ys.transpose(1, 0, 2, 3, 4).reshape(n_b, n_t, SSM_WIDTH)
    else:
        y_ssm, h_re_new, h_im_new = _s5_segment(ug, h_re.astype(f32), h_im.astype(f32), abar_re, abar_im,
                                                bbar_re, bbar_im, c_re, c_im, d_skip)
        y_ssm = y_ssm.reshape(n_b, n_t, SSM_WIDTH)
    y_ssm = jax.nn.gelu(y_ssm)
    y_ssm = y_ssm * jax.nn.sigmoid(y_ssm @ w_glu.astype(f32) + b_glu.astype(f32))
    y_ssm = (y_ssm * jax.nn.silu(z_s.astype(f32))).astype(x.dtype)

    q = _rmsnorm(q.reshape(n_b, n_t, N_HEADS, HEAD_DIM), q_norm_g)
    k = _rmsnorm(k.reshape(n_b, n_t, N_HEADS, HEAD_DIM), k_norm_g)
    v = v.reshape(n_b, n_t, N_HEADS, HEAD_DIM)
    logf = jax.nn.log_sigmoid((f_logit + b_f).astype(f32))
    if past is None:
        cum = jnp.cumsum(logf, axis=1)
        pos = jnp.arange(n_t)
        n_qb = n_t // Q_BLOCK
        qb = q.reshape(n_b, n_qb, Q_BLOCK, N_HEADS, HEAD_DIM).transpose(1, 0, 2, 3, 4)
        cb = cum.reshape(n_b, n_qb, Q_BLOCK, N_HEADS).transpose(1, 0, 2, 3)
        pb = pos.reshape(n_qb, Q_BLOCK)
        ob = lax.map(lambda blk: _fox_attend(blk[0], blk[1], blk[2], k, v, cum, pos), (qb, cb, pb))
        o = ob.transpose(1, 0, 2, 3, 4).reshape(n_b, n_t, ATTN_WIDTH)
    else:
        ck, cv, clogf = past
        n_past = ck.shape[1]
        k_all = jnp.concatenate([ck.astype(k.dtype), k], axis=1)
        v_all = jnp.concatenate([cv.astype(v.dtype), v], axis=1)
        cum = jnp.cumsum(jnp.concatenate([clogf.astype(f32), logf], axis=1), axis=1)
        pos_k = jnp.arange(n_past + n_t)
        o = _fox_attend(q, cum[:, n_past:], pos_k[n_past:], k_all, v_all, cum, pos_k)
        o = o.reshape(n_b, n_t, ATTN_WIDTH)
    y_att = (o.astype(f32) * jax.nn.silu(z_a.astype(f32))).astype(x.dtype)

    mixed = jnp.concatenate([y_ssm, y_att], axis=-1)
    y = x + gate[:, None, :] * (mixed @ w_out)
    return y, k, v, logf, h_re_new, h_im_new


def setup_inputs(seed: int = 0) -> dict:
    key = jax.random.key(seed)
    ks = jax.random.split(key, 32)
    f32 = jnp.float32

    def nrm(k, shape, s):
        return s * jax.random.normal(k, shape, f32)

    G, N, P = SSM_GROUPS, SSM_STATE, SSM_GROUP
    x_prompt = nrm(ks[0], (BATCH, SEQ, D_MODEL), 1.0)
    x_sample = nrm(ks[1], (DEC_BATCH, DEC_SEQ, D_MODEL), 1.0)
    cache_k = nrm(ks[2], (DEPTH, DEC_BATCH, PAST_LEN, N_HEADS, HEAD_DIM), 1.0)
    cache_v = nrm(ks[3], (DEPTH, DEC_BATCH, PAST_LEN, N_HEADS, HEAD_DIM), 1.0)
    cache_logf = jax.nn.log_sigmoid(2.0 + nrm(ks[4], (DEPTH, DEC_BATCH, PAST_LEN, N_HEADS), 0.5))
    state_ssm_re = nrm(ks[5], (DEPTH, DEC_BATCH, G, N), 0.1)
    state_ssm_im = nrm(ks[6], (DEPTH, DEC_BATCH, G, N), 0.1)
    c_prompt = nrm(ks[7], (BATCH, D_MODEL), 1.0)
    c_sample = nrm(ks[8], (DEC_BATCH, D_MODEL), 1.0)
    w_ada = nrm(ks[9], (DEPTH, D_MODEL, 3 * D_MODEL), 0.5 * D_MODEL ** -0.5)
    b_ada = nrm(ks[10], (DEPTH, 3 * D_MODEL), 0.02)
    norm_g = 1.0 + nrm(ks[11], (DEPTH, D_MODEL), 0.02)
    w_in = nrm(ks[12], (DEPTH, D_MODEL, IN_WIDTH), D_MODEL ** -0.5)
    b_f = jax.random.uniform(ks[13], (DEPTH, N_HEADS), f32, 1.0, 3.0)
    q_norm_g = 1.0 + nrm(ks[14], (DEPTH, HEAD_DIM), 0.02)
    k_norm_g = 1.0 + nrm(ks[15], (DEPTH, HEAD_DIM), 0.02)
    ssm_log_dt = jax.random.uniform(ks[16], (DEPTH, G), f32, math.log(1e-3), math.log(1e-1))
    ssm_a_re = -0.5 + nrm(ks[17], (DEPTH, G, N), 0.01)
    ssm_a_im = math.pi * jnp.arange(N, dtype=f32) + nrm(ks[18], (DEPTH, G, N), 0.01)
    ssm_b_re = nrm(ks[19], (DEPTH, G, N, P), (2 * P) ** -0.5)
    ssm_b_im = nrm(ks[20], (DEPTH, G, N, P), (2 * P) ** -0.5)
    ssm_c_re = nrm(ks[21], (DEPTH, G, P, N), N ** -0.5)
    ssm_c_im = nrm(ks[22], (DEPTH, G, P, N), N ** -0.5)
    ssm_d = nrm(ks[23], (DEPTH, G, P), 1.0)
    w_glu = nrm(ks[24], (DEPTH, SSM_WIDTH, SSM_WIDTH), SSM_WIDTH ** -0.5)
    b_glu = nrm(ks[25], (DEPTH, SSM_WIDTH), 0.02)
    w_out = nrm(ks[26], (DEPTH, D_MIX, D_MODEL), D_MIX ** -0.5)
    return {'x_prompt': x_prompt, 'x_sample': x_sample, 'cache_k': cache_k, 'cache_v': cache_v,
            'cache_logf': cache_logf, 'state_ssm_re': state_ssm_re, 'state_ssm_im': state_ssm_im,
            'c_prompt': c_prompt, 'c_sample': c_sample, 'w_ada': w_ada, 'b_ada': b_ada, 'norm_g': norm_g,
            'w_in': w_in, 'b_f': b_f, 'q_norm_g': q_norm_g, 'k_norm_g': k_norm_g, 'ssm_log_dt': ssm_log_dt,
            'ssm_a_re': ssm_a_re, 'ssm_a_im': ssm_a_im, 'ssm_b_re': ssm_b_re, 'ssm_b_im': ssm_b_im,
            'ssm_c_re': ssm_c_re, 'ssm_c_im': ssm_c_im, 'ssm_d': ssm_d, 'w_glu': w_glu, 'b_glu': b_glu,
            'w_out': w_out}


def reference(x_prompt, x_sample, cache_k, cache_v, cache_logf, state_ssm_re, state_ssm_im,
              c_prompt, c_sample, w_ada, b_ada, norm_g, w_in, b_f, q_norm_g, k_norm_g,
              ssm_log_dt, ssm_a_re, ssm_a_im, ssm_b_re, ssm_b_im, ssm_c_re, ssm_c_im, ssm_d,
              w_glu, b_glu, w_out):
    xp = x_prompt
    xs = x_sample
    kp, vp, fp, rp, ip = [], [], [], [], []
    ks_, vs_, fs_, rs_, is_ = [], [], [], [], []
    for l in range(DEPTH):
        lw = (w_ada[l], b_ada[l], norm_g[l], w_in[l], b_f[l], q_norm_g[l], k_norm_g[l],
              ssm_log_dt[l], ssm_a_re[l], ssm_a_im[l], ssm_b_re[l], ssm_b_im[l],
              ssm_c_re[l], ssm_c_im[l], ssm_d[l], w_glu[l], b_glu[l], w_out[l])
        xp, k1, v1, f1, r1, i1 = _layer(xp, c_prompt, None, None, None, *lw)
        xs, k2, v2, f2, r2, i2 = _layer(xs, c_sample, state_ssm_re[l], state_ssm_im[l],
                                        (cache_k[l], cache_v[l], cache_logf[l]), *lw)
        kp.append(k1); vp.append(v1); fp.append(f1); rp.append(r1); ip.append(i1)
        ks_.append(k2); vs_.append(v2); fs_.append(f2); rs_.append(r2); is_.append(i2)
    return (xp, xs, jnp.stack(kp), jnp.stack(vp), jnp.stack(fp), jnp.stack(rp), jnp.stack(ip),
            jnp.stack(ks_), jnp.stack(vs_), jnp.stack(fs_), jnp.stack(rs_), jnp.stack(is_))
```

```cpp
#include <hip/hip_runtime.h>
#include <hip/hip_cooperative_groups.h>
#include <hip/hip_bf16.h>
#include <cstdio>
#include <cstdint>
#include <cmath>
namespace cg = cooperative_groups;

#define LAS __attribute__((address_space(3)))
typedef unsigned short bf16_t;
typedef short bf16x8 __attribute__((ext_vector_type(8)));
typedef short s16x4 __attribute__((ext_vector_type(4)));
typedef float f32x4 __attribute__((ext_vector_type(4)));
typedef float f32x2 __attribute__((ext_vector_type(2)));
typedef float f32x16 __attribute__((ext_vector_type(16)));
typedef unsigned u32x4 __attribute__((ext_vector_type(4)));
typedef unsigned u32x2 __attribute__((ext_vector_type(2)));

constexpr int DM = 1024, NB = 8, SEQ = 8192, PT = NB * SEQ  , ST = 512, MT = PT + ST  , DSEQ = 64, PAST = 2048, SKV = PAST + DSEQ  ;
constexpr int NH = 8, HD = 64, SW = 512, AW = 512, NG = 32, SP = 16, SN = 64, INW = 3080, NPROJ = 3072;
constexpr int CL = 16;
constexpr int NCH = PT / CL;
constexpr int UXR = 24;
constexpr int UXROWS = NCH + ST / CL;
__host__ __device__ __forceinline__ size_t ux_off(int m, int ch) { return ((size_t)((ch >> 4) * UXROWS + (m >> 4)) * UXR + (m & 15)) * 16 + (ch & 15); }
__host__ __device__ __forceinline__ size_t ys_off(int m, int ch) { return ((size_t)(ch >> 4) * PT + m) * 16 + (ch & 15); }
constexpr float NORM_EPS = 1e-6f;
constexpr float LOG2E = 1.4426950408889634f;
constexpr float C2 = 0.125f * LOG2E;

constexpr size_t O_YP = 0, O_YS = O_YP + (size_t)PT * DM, O_KP = O_YS + (size_t)ST * DM, O_VP = O_KP + (size_t)PT * AW, O_LFP = O_VP + (size_t)PT * AW,
                 O_RP = O_LFP + (size_t)PT * NH, O_IP = O_RP + NB * NG * SN, O_KS = O_IP + NB * NG * SN, O_VS = O_KS + (size_t)ST * AW, O_LFS = O_VS + (size_t)ST * AW,
                 O_RS = O_LFS + ST * NH, O_IS = O_RS + NB * NG * SN, O_END = O_IS + NB * NG * SN;

constexpr size_t MiB = 1u << 20;
constexpr size_t WS_CTL = 0, CTL_BYTES = 65536;
constexpr size_t WS_MOD = 1 * MiB;
constexpr size_t WS_A16 = WS_MOD + 256 * 1024;
constexpr size_t WS_ABAR = WS_A16 + 16384;
constexpr size_t WS_BBAR = WS_ABAR + 16384;
constexpr size_t WS_WIN = 2 * MiB;
constexpr size_t WS_WGLU = 8 * MiB;
constexpr size_t WS_WOUT = 9 * MiB;
constexpr size_t WS_W1 = 11 * MiB;
constexpr size_t WS_W2 = 15 * MiB;
constexpr size_t WS_XN = 24 * MiB;
constexpr size_t WS_UX = 160 * MiB;
constexpr size_t WS_ZS = 260 * MiB, WS_Q = 328 * MiB, WS_ZA = 396 * MiB;
constexpr size_t WS_KB = 464 * MiB, WS_VB = 528 * MiB;
constexpr size_t WS_KS = 592 * MiB, WS_VS = 609 * MiB;
constexpr size_t WS_LFS = 626 * MiB;
constexpr size_t WS_SB = 627 * MiB;
constexpr size_t WS_YS = 692 * MiB;
constexpr size_t WS_YSS = 757 * MiB;
constexpr size_t WS_END = 760 * MiB;

constexpr int NWAVES = 8, NTHR = 512;
constexpr int REP_P0 = 1, REP_P1 = 1, REP_P2 = 1, REP_P3 = 1, REP_CH = 1, REP_ATT = 1, REP_P5 = 1, REP_P6 = 1, REP_P7 = 1, EXTRA_SYNCS = 0;
constexpr int LDS_BYTES = 147456;
constexpr int RING_BYTES = 131072, MISC_OFF = RING_BYTES + 320;

__device__ __forceinline__ unsigned f2bf(float f) { unsigned u = __builtin_bit_cast(unsigned, f); return (u + 0x7fffu + ((u >> 16) & 1u)) >> 16; }
__device__ __forceinline__ unsigned pk2(float lo, float hi) { typedef __bf16 bf16x2_t_ __attribute__((ext_vector_type(2))); f32x2 v = {lo, hi}; return __builtin_bit_cast(unsigned, __builtin_convertvector(v, bf16x2_t_)); }
__device__ __forceinline__ float bf2f(unsigned short b) { return __builtin_bit_cast(float, (unsigned)b << 16); }
__device__ __forceinline__ float bflo(unsigned w) { return __builtin_bit_cast(float, w << 16); }
__device__ __forceinline__ float bfhi(unsigned w) { return __builtin_bit_cast(float, w & 0xffff0000u); }
__device__ __forceinline__ float sigmoidf_(float x) { return __builtin_amdgcn_rcpf(1.f + __expf(-x)); }
__device__ __forceinline__ float siluf_(float x) { return x * __builtin_amdgcn_rcpf(1.f + __expf(-x)); }
__device__ __forceinline__ float gelu_tanh(float x) { const float z = 0.7978845608028654f * (x + 0.044715f * x * x * x); return x * __builtin_amdgcn_rcpf(1.f + __expf(-2.f * z)); }

namespace pg8 {
constexpr int BM = 256, BK = 64, HALF = 128, HTB = HALF * BK * 2, STAGE_BYTES = 8 * HTB, NXCD = 8, WGM = 8;
__host__ __device__ __forceinline__ int lds_byte(int r, int c) { const int st = (r >> 4) * 2 + (c >> 5), rr = r & 15, cc = c & 31, ob = rr * 64 + cc * 2; return st * 1024 + (ob ^ (((ob >> 9) & 1) << 5)); }
__host__ __device__ __forceinline__ void stage_rc(int b, int& R, int& C) { const int st = b / 1024, sb = b % 1024, swz = sb ^ (((sb >> 9) & 1) << 5); R = (st >> 1) * 16 + swz / 64; C = (st & 1) * 32 + (swz % 64) / 2; }
__host__ __device__ __forceinline__ int perm32(int rho) { const int n = rho >> 4, i = rho & 15; return 8 * (i >> 2) + 4 * n + (i & 3); }

struct Unit { int pm, pn, g; const char* a; const char* b; };
struct Gemm { unsigned lda, ldb; size_t kstepA, kstepB; int nt; unsigned aplane; };

struct StaticOrder {
    int nM, nN, nwg, G, c; const char* A; const char* B; size_t ta, tb;
    __device__ void init(int M, int N, int G_, int c_, const void* A_, const void* B_, unsigned lda, unsigned ldb) { nM = M / BM; nN = N / BM; nwg = nM * nN; G = G_; c = c_; A = (const char*)A_; B = (const char*)B_; ta = (size_t)BM * lda; tb = (size_t)BM * ldb; }
    __device__ bool next(int i, Unit& u) const {
        const long L = (long)i * G + c; if (L >= nwg) return false;
        int wgid = (int)L; { const int q = nwg / NXCD, r = nwg % NXCD, xcd = wgid % NXCD, off = wgid / NXCD; wgid = (xcd < r ? xcd * (q + 1) : r * (q + 1) + (xcd - r) * q) + off; }
        const int nig = WGM * nN, gid = wgid / nig, fm = gid * WGM, gsz = (nM - fm) < WGM ? (nM - fm) : WGM;
        u.pm = fm + ((wgid % nig) % gsz); u.pn = (wgid % nig) / gsz; u.g = 0; u.a = A + (size_t)u.pm * ta; u.b = B + (size_t)u.pn * tb; return true;
    }
};
struct S5Order {
    int G, c; const char* A; const char* B; size_t wbytes;
    __device__ bool next(int i, Unit& u) const {
        const int L = i * G + c; if (L >= NG * (NCH / BM)) return false;
        u.g = L / (NCH / BM); u.pm = L % (NCH / BM); u.pn = 0;
        u.a = A + ((size_t)u.g * UXROWS + (size_t)u.pm * BM) * (UXR * 32); u.b = B + (size_t)u.g * wbytes; return true;
    }
};

template <class Epi, class Sched>
__device__ __forceinline__ void gemm_phase(LAS unsigned char* lds, const Gemm g, const Sched& S, const Epi& E) {
    int tid_ = threadIdx.x; asm volatile("" : "+v"(tid_));
    const int tid = tid_, wid = __builtin_amdgcn_readfirstlane(tid >> 6), lane = tid & 63, wr = wid >> 2, wc = wid & 3, fr = lane & 15, fq = lane >> 4;
    const int nt = g.nt;
    unsigned voffA[2], voffB[2];
#pragma unroll
    for (int i = 0; i < 2; ++i) { int R, C; stage_rc(tid * 16 + i * 8192, R, C); const int Rb = Epi::PERM ? ((R & ~31) + perm32(R & 31)) : R;
        voffA[i] = (unsigned)R * g.lda + (g.aplane ? (unsigned)(C >> 4) * g.aplane + (unsigned)((C & 15) * 2) : (unsigned)(C * 2)); voffB[i] = (unsigned)Rb * g.ldb + (unsigned)(C * 2); }
    const size_t kstepA = g.kstepA, kstepB = g.kstepB;
    const size_t hstepA = (size_t)HALF * g.lda, hstepB = (size_t)HALF * g.ldb;
    const unsigned ldsw = (unsigned)wid * 1024u;
    const int aoff = lds_byte(wr * 64 + fr, fq * 8), boff = lds_byte(wc * 32 + fr, fq * 8);
#define PG8_SA(b, h) (((b) * 2 + (h)) * HTB)
#define PG8_SB(b, h) ((4 + (b) * 2 + (h)) * HTB)
#define PG8_STAGE(bufoff, gbase, voff) do { _Pragma("unroll") for (int _i = 0; _i < 2; ++_i) \
        __builtin_amdgcn_global_load_lds((const unsigned*)((const char*)(gbase) + (voff)[_i]), (LAS unsigned*)(lds + (bufoff) + ldsw + _i * 8192), 16, 0, 0); } while (0)
#define PG8_LDA(dst, b, h) do { _Pragma("unroll") for (int m = 0; m < 4; ++m) _Pragma("unroll") for (int k = 0; k < 2; ++k) dst[m][k] = *(const LAS bf16x8*)(lds + PG8_SA(b, h) + aoff + m * 2048 + k * 1024); } while (0)
#define PG8_LDB(dst, b, h) do { _Pragma("unroll") for (int n = 0; n < 2; ++n) _Pragma("unroll") for (int k = 0; k < 2; ++k) dst[n][k] = *(const LAS bf16x8*)(lds + PG8_SB(b, h) + boff + n * 2048 + k * 1024); } while (0)
#define PG8_MMA(ai, bj, At, Bt) do { __builtin_amdgcn_s_setprio(1); _Pragma("unroll") for (int m = 0; m < 4; ++m) _Pragma("unroll") for (int n = 0; n < 2; ++n) _Pragma("unroll") for (int k = 0; k < 2; ++k) \
        acc[ai][bj][m][n] = __builtin_amdgcn_mfma_f32_16x16x32_bf16(Bt[n][k], At[m][k], acc[ai][bj][m][n], 0, 0, 0); __builtin_amdgcn_s_setprio(0); } while (0)
#define PG8_WAIT_V(n) asm volatile("s_waitcnt vmcnt(" #n ")" ::: "memory")
#define PG8_WAIT_SEL(flag, n) asm volatile("s_cmp_eq_u32 %0, 0\n\ts_cbranch_scc1 .Lrwa%=\n\ts_waitcnt vmcnt(%1)\n\ts_branch .Lrwb%=\n.Lrwa%=:\n\ts_waitcnt vmcnt(8)\n.Lrwb%=:" :: "s"(flag), "n"(n) : "memory", "scc")
#define PG8_WAIT_L(n) asm volatile("s_waitcnt lgkmcnt(" #n ")" ::: "memory")
#define PG8_BAR __builtin_amdgcn_s_barrier()
#define PG8_SCHED __builtin_amdgcn_sched_barrier(0)
    Unit cur, nxt; int ui = 0;
    if (!S.next(0, cur)) return;
    f32x4 acc[2][2][4][2];
#pragma unroll
    for (int a = 0; a < 2; ++a)
#pragma unroll
        for (int b = 0; b < 2; ++b)
#pragma unroll
            for (int m = 0; m < 4; ++m)
#pragma unroll
                for (int n = 0; n < 2; ++n) acc[a][b][m][n] = (f32x4){0.f, 0.f, 0.f, 0.f};
    bf16x8 At[4][2], B0[2][2], B1[2][2];
    const char* cA = cur.a; const char* cB = cur.b;
    PG8_WAIT_V(0);
    PG8_STAGE(PG8_SB(0, 0), cB, voffB); PG8_STAGE(PG8_SB(0, 1), cB + hstepB, voffB); PG8_STAGE(PG8_SA(0, 0), cA, voffA); PG8_STAGE(PG8_SA(0, 1), cA + hstepA, voffA);
    if (wr == 1) PG8_BAR;
    PG8_WAIT_V(2); PG8_BAR;
    PG8_STAGE(PG8_SB(1, 0), cB + kstepB, voffB); PG8_STAGE(PG8_SA(1, 0), cA + kstepA, voffA); PG8_STAGE(PG8_SB(1, 1), cB + hstepB + kstepB, voffB);
    PG8_WAIT_V(6); PG8_BAR;
    for (;;) {
        const bool has_next = S.next(ui + 1, nxt);
        const char* nA = has_next ? nxt.a : cA; const char* nB = has_next ? nxt.b : cB;
        for (int t = 0; t < nt; t += 2) {
            const bool last = (t == nt - 2);
            const char* a1 = cA + (size_t)(t + 1) * kstepA;
            const char* a2 = last ? nA : cA + (size_t)(t + 2) * kstepA; const char* b2 = last ? nB : cB + (size_t)(t + 2) * kstepB;
            const char* a3 = a2 + kstepA; const char* b3 = b2 + kstepB;
            int relax_v = ((t == 0) && (ui > 0)) ? 1 : 0; asm volatile("" : "+v"(relax_v)); const int relax = __builtin_amdgcn_readfirstlane(relax_v);
            PG8_LDB(B0, 0, 0); PG8_LDB(B1, 0, 1); PG8_SCHED; PG8_LDA(At, 0, 0); PG8_STAGE(PG8_SA(1, 1), a1 + hstepA, voffA);
            PG8_WAIT_SEL(relax, 8 + Epi::NST);
            PG8_WAIT_L(0); PG8_BAR; PG8_MMA(0, 0, At, B0); PG8_MMA(0, 1, At, B1); PG8_BAR; PG8_SCHED;
            PG8_LDA(At, 0, 1); PG8_STAGE(PG8_SB(0, 0), b2, voffB); PG8_STAGE(PG8_SB(0, 1), b2 + hstepB, voffB); PG8_STAGE(PG8_SA(0, 0), a2, voffA);
            PG8_WAIT_SEL(relax, 8 + Epi::NST);
            PG8_WAIT_L(0); PG8_BAR; PG8_MMA(1, 0, At, B0); PG8_MMA(1, 1, At, B1); PG8_BAR; PG8_SCHED;
            PG8_LDB(B0, 1, 0); PG8_LDB(B1, 1, 1); PG8_SCHED; PG8_LDA(At, 1, 0); PG8_STAGE(PG8_SA(0, 1), a2 + hstepA, voffA);
            PG8_WAIT_V(8); PG8_WAIT_L(0); PG8_BAR; PG8_MMA(0, 0, At, B0); PG8_MMA(0, 1, At, B1); PG8_BAR; PG8_SCHED;
            PG8_LDA(At, 1, 1); PG8_STAGE(PG8_SB(1, 0), b3, voffB); PG8_STAGE(PG8_SB(1, 1), b3 + hstepB, voffB); PG8_STAGE(PG8_SA(1, 0), a3, voffA);
            PG8_WAIT_V(8); PG8_WAIT_L(0); PG8_BAR; PG8_MMA(1, 0, At, B0); PG8_MMA(1, 1, At, B1); PG8_BAR; PG8_SCHED;
        }
        if (wr == 0) PG8_BAR;
        E(acc, cur, wr, wc, fr, fq);
        if (!has_next) break;
#pragma unroll
        for (int a = 0; a < 2; ++a)
#pragma unroll
            for (int b = 0; b < 2; ++b)
#pragma unroll
                for (int m = 0; m < 4; ++m)
#pragma unroll
                    for (int n = 0; n < 2; ++n) acc[a][b][m][n] = (f32x4){0.f, 0.f, 0.f, 0.f};
        cur = nxt; cA = nA; cB = nB; ++ui;
        if (wr == 1) PG8_BAR;
    }
    PG8_WAIT_V(0);
    PG8_BAR;
#undef PG8_SA
#undef PG8_SB
#undef PG8_STAGE
#undef PG8_LDA
#undef PG8_LDB
#undef PG8_MMA
#undef PG8_WAIT_V
#undef PG8_WAIT_SEL
#undef PG8_WAIT_L
#undef PG8_BAR
#undef PG8_SCHED
}
}

struct Params {
    const float *x_prompt, *x_sample, *cache_k, *cache_v, *cache_logf, *st_re, *st_im, *c_prompt, *c_sample, *w_ada, *b_ada, *norm_g, *w_in, *b_f, *q_g, *k_g,
                *log_dt, *a_re, *a_im, *b_re, *b_im, *c_re, *c_im, *d_skip, *w_glu, *b_glu, *w_out;
    float* out; unsigned char* ws;
};

struct EpiInProj {
    static constexpr bool PERM = true; static constexpr int NST = 16;
    bf16_t *UX_, *ZS_, *Q, *ZA_, *KB_, *VB_, *KS_, *VS_; float *kp, *vp, *ksm, *vsm; const float *gq, *gk;
    __device__ __forceinline__ void operator()(const f32x4 (&acc)[2][2][4][2], const pg8::Unit& u, int wr, int wc, int fr, int fq) const {
        const int type = u.pn >> 1;
        const int cb0 = (u.pn & 1) * 256 + wc * 64 + fq * 8;
        float gg[2][8];
        if (type == 2 || type == 3) { const float* gp = (type == 2) ? gq : gk;
#pragma unroll
            for (int bj = 0; bj < 2; ++bj)
#pragma unroll
                for (int e = 0; e < 8; ++e) gg[bj][e] = gp[bj * 32 + fq * 8 + e] * (type == 2 ? C2 : 1.f); }
#pragma unroll
        for (int ai = 0; ai < 2; ++ai)
#pragma unroll
            for (int m = 0; m < 4; ++m) {
                const int row = u.pm * 256 + ai * 128 + wr * 64 + m * 16 + fr;
                float v[2][8];
#pragma unroll
                for (int bj = 0; bj < 2; ++bj)
#pragma unroll
                    for (int e = 0; e < 4; ++e) { v[bj][e] = acc[ai][bj][m][0][e]; v[bj][4 + e] = acc[ai][bj][m][1][e]; }
                if (type == 2 || type == 3) {
                    float ss = 0.f;
#pragma unroll
                    for (int bj = 0; bj < 2; ++bj)
#pragma unroll
                        for (int e = 0; e < 8; ++e) ss += v[bj][e] * v[bj][e];
                    ss += __shfl_xor(ss, 16); ss += __shfl_xor(ss, 32);
                    const float rs = rsqrtf(ss * (1.f / 64.f) + NORM_EPS);
#pragma unroll
                    for (int bj = 0; bj < 2; ++bj)
#pragma unroll
                        for (int e = 0; e < 8; ++e) v[bj][e] = v[bj][e] * rs * gg[bj][e];
                } else if (type == 1 || type == 5) {
#pragma unroll
                    for (int bj = 0; bj < 2; ++bj)
#pragma unroll
                        for (int e = 0; e < 8; ++e) v[bj][e] = siluf_(v[bj][e]);
                }
                bf16_t* bdst; float* fdst = nullptr;
                if (type == 0) bdst = UX_;
                else if (type == 1) bdst = ZS_ + (size_t)row * 512;
                else if (type == 2) bdst = Q + (size_t)row * 512;
                else if (type == 5) bdst = ZA_ + (size_t)row * 512;
                else {
                    if (row < PT) { bdst = (type == 3 ? KB_ : VB_) + (size_t)row * 512; fdst = (type == 3 ? kp : vp) + (size_t)row * 512; }
                    else { const int s = row - PT, b = s >> 6, t = s & 63; bdst = (type == 3 ? KS_ : VS_) + (size_t)(b * SKV + PAST + t) * 512; fdst = (type == 3 ? ksm : vsm) + (size_t)s * 512; }
                }
#pragma unroll
                for (int bj = 0; bj < 2; ++bj) {
                    u32x4 w; w.x = pk2(v[bj][0], v[bj][1]); w.y = pk2(v[bj][2], v[bj][3]); w.z = pk2(v[bj][4], v[bj][5]); w.w = pk2(v[bj][6], v[bj][7]);
                    *(u32x4*)(bdst + (type == 0 ? ux_off(row, cb0 + bj * 32) : (size_t)(cb0 + bj * 32))) = w;
                    if (fdst) { *(f32x4*)(fdst + cb0 + bj * 32) = (f32x4){v[bj][0], v[bj][1], v[bj][2], v[bj][3]}; *(f32x4*)(fdst + cb0 + bj * 32 + 4) = (f32x4){v[bj][4], v[bj][5], v[bj][6], v[bj][7]}; }
                }
            }
    }
};
struct EpiS {
    static constexpr bool PERM = true; static constexpr int NST = 16;
    float* SB_;
    __device__ __forceinline__ void operator()(const f32x4 (&acc)[2][2][4][2], const pg8::Unit& u, int wr, int wc, int fr, int fq) const {
#pragma unroll
        for (int ai = 0; ai < 2; ++ai)
#pragma unroll
            for (int m = 0; m < 4; ++m) {
                const int row = u.pm * 256 + ai * 128 + wr * 64 + m * 16 + fr;
                float* d = SB_ + ((size_t)u.g * NCH + row) * 128 + wc * 32 + fq * 8;
                *(f32x4*)d = acc[ai][0][m][0]; *(f32x4*)(d + 4) = acc[ai][0][m][1];
            }
    }
};
struct EpiY {
    static constexpr bool PERM = true; static constexpr int NST = 16;
    bf16_t* YS_;
    __device__ __forceinline__ void operator()(const f32x4 (&acc)[2][2][4][2], const pg8::Unit& u, int wr, int wc, int fr, int fq) const {
#pragma unroll
        for (int ai = 0; ai < 2; ++ai)
#pragma unroll
            for (int m = 0; m < 4; ++m) {
                const int row = u.pm * 256 + ai * 128 + wr * 64 + m * 16 + fr;
#pragma unroll
                for (int bj = 0; bj < 2; ++bj) {
                    const int t = 8 * bj + 2 * wc + (fq >> 1), p0 = 8 * (fq & 1);
                    const f32x4 a = acc[ai][bj][m][0], b = acc[ai][bj][m][1];
                    u32x4 w; w.x = pk2(gelu_tanh(a[0]), gelu_tanh(a[1])); w.y = pk2(gelu_tanh(a[2]), gelu_tanh(a[3])); w.z = pk2(gelu_tanh(b[0]), gelu_tanh(b[1])); w.w = pk2(gelu_tanh(b[2]), gelu_tanh(b[3]));
                    *(u32x4*)(YS_ + ys_off(row * CL + t, u.g * 16 + p0)) = w;
                }
            }
    }
};
struct EpiGlu {
    static constexpr bool PERM = true; static constexpr int NST = 16;
    const bf16_t *YS_, *ZS_; const float* bglu; bf16_t* MX_;
    __device__ __forceinline__ void operator()(const f32x4 (&acc)[2][2][4][2], const pg8::Unit& u, int wr, int wc, int fr, int fq) const {
#pragma unroll
        for (int bj = 0; bj < 2; ++bj) {
            const int col = u.pn * 256 + bj * 128 + wc * 32 + fq * 8;
            const f32x4 b0 = *(const f32x4*)(bglu + col), b1 = *(const f32x4*)(bglu + col + 4);
#pragma unroll
            for (int ai = 0; ai < 2; ++ai) {
                u32x4 ysv[4], zsv[4];
#pragma unroll
                for (int m = 0; m < 4; ++m) { const int row = u.pm * 256 + ai * 128 + wr * 64 + m * 16 + fr;
                    ysv[m] = *(const u32x4*)(YS_ + ys_off(row, col)); zsv[m] = *(const u32x4*)(ZS_ + (size_t)row * 512 + col); }
                asm volatile("" ::: "memory");
#pragma unroll
                for (int m = 0; m < 4; ++m) {
                    const int row = u.pm * 256 + ai * 128 + wr * 64 + m * 16 + fr;
                    const u32x4 ys = ysv[m], zs = zsv[m];
                    const f32x4 a = acc[ai][bj][m][0] + b0, b = acc[ai][bj][m][1] + b1;
                    u32x4 w;
                    w.x = pk2(bflo(ys.x) * sigmoidf_(a[0]) * bflo(zs.x), bfhi(ys.x) * sigmoidf_(a[1]) * bfhi(zs.x));
                    w.y = pk2(bflo(ys.y) * sigmoidf_(a[2]) * bflo(zs.y), bfhi(ys.y) * sigmoidf_(a[3]) * bfhi(zs.y));
                    w.z = pk2(bflo(ys.z) * sigmoidf_(b[0]) * bflo(zs.z), bfhi(ys.z) * sigmoidf_(b[1]) * bfhi(zs.z));
                    w.w = pk2(bflo(ys.w) * sigmoidf_(b[2]) * bflo(zs.w), bfhi(ys.w) * sigmoidf_(b[3]) * bfhi(zs.w));
                    *(u32x4*)(MX_ + (size_t)row * 1024 + col) = w;
                }
                asm volatile("" ::: "memory");
            }
            asm volatile("" ::: "memory");
        }
    }
};
struct EpiOut {
    static constexpr bool PERM = false; static constexpr int NST = 32;
    const float *xp, *xs, *mod; float *yp, *ys;
    __device__ __forceinline__ void operator()(const f32x4 (&acc)[2][2][4][2], const pg8::Unit& u, int wr, int wc, int fr, int fq) const {
        const int row0 = u.pm * 256 + wr * 64 + fr, col0 = u.pn * 256 + wc * 32 + fq * 4;
        const float* gt = mod + (size_t)(row0 >> 13) * 3072 + 2048 + col0;
        f32x4 gv[2][2];
#pragma unroll
        for (int bj = 0; bj < 2; ++bj)
#pragma unroll
            for (int n = 0; n < 2; ++n) gv[bj][n] = *(const f32x4*)(gt + bj * 128 + 16 * n);
#pragma unroll
        for (int ai = 0; ai < 2; ++ai)
#pragma unroll
            for (int mp = 0; mp < 2; ++mp) {
                f32x4 xv[2][2][2];
#pragma unroll
                for (int mm = 0; mm < 2; ++mm) { const float* xr = xp + (size_t)(row0 + ai * 128 + (2 * mp + mm) * 16) * DM + col0;
#pragma unroll
                    for (int bj = 0; bj < 2; ++bj)
#pragma unroll
                        for (int n = 0; n < 2; ++n) xv[mm][bj][n] = *(const f32x4*)(xr + bj * 128 + 16 * n); }
                asm volatile("" ::: "memory");
#pragma unroll
                for (int mm = 0; mm < 2; ++mm) { float* yr = yp + (size_t)(row0 + ai * 128 + (2 * mp + mm) * 16) * DM + col0;
#pragma unroll
                    for (int bj = 0; bj < 2; ++bj)
#pragma unroll
                        for (int n = 0; n < 2; ++n) { const f32x4 yv = xv[mm][bj][n] + gv[bj][n] * acc[ai][bj][2 * mp + mm][n]; const float* yp_ = yr + bj * 128 + 16 * n;
                            asm volatile("global_store_dwordx4 %0, %1, off sc1" :: "v"(yp_), "v"(yv) : "memory"); } }
                asm volatile("" ::: "memory");
            }
    }
};

namespace att {
constexpr int LDS_K = 0, LDS_V = 8192, LDS_WS = 32768, LDS_LX = 36864, LDS_OST = 37888, LDS_UNIT = 70656;
__device__ __forceinline__ int crow(int r, int hi) { return (r & 3) + 8 * (r >> 2) + 4 * hi; }
__device__ __forceinline__ unsigned cvtpk(float lo, float hi) { typedef __bf16 bf16x2_t __attribute__((ext_vector_type(2))); f32x2 v = {lo, hi}; bf16x2_t b = __builtin_convertvector(v, bf16x2_t); return __builtin_bit_cast(unsigned, b); }
struct UnitDesc { const bf16_t* Q; const bf16_t* K; const bf16_t* V; const float* LF; const bf16_t* Zg; bf16_t* O; int q0, nq; };

__device__ __forceinline__ void pv(f32x16* o, int vb, bf16x8 pa0, bf16x8 pa1, bf16x8 pa2, bf16x8 pa3) {
#pragma unroll
    for (int d0 = 0; d0 < 2; ++d0) { s16x4 lo[4], hi[4];
#pragma unroll
        for (int ks = 0; ks < 4; ++ks) {
            asm volatile("ds_read_b64_tr_b16 %0,%1 offset:%c2" : "=&v"(lo[ks]) : "v"(vb), "i"(d0 * 4096 + ks * 1024) : "memory");
            asm volatile("ds_read_b64_tr_b16 %0,%1 offset:%c2" : "=&v"(hi[ks]) : "v"(vb), "i"(d0 * 4096 + ks * 1024 + 512) : "memory"); }
        asm volatile("s_waitcnt lgkmcnt(0)" ::: "memory"); __builtin_amdgcn_sched_barrier(0);
#define PK(k) (bf16x8){lo[k][0], lo[k][1], lo[k][2], lo[k][3], hi[k][0], hi[k][1], hi[k][2], hi[k][3]}
        o[d0] = __builtin_amdgcn_mfma_f32_32x32x16_bf16(pa0, PK(0), o[d0], 0, 0, 0);
        o[d0] = __builtin_amdgcn_mfma_f32_32x32x16_bf16(pa1, PK(1), o[d0], 0, 0, 0);
        o[d0] = __builtin_amdgcn_mfma_f32_32x32x16_bf16(pa2, PK(2), o[d0], 0, 0, 0);
        o[d0] = __builtin_amdgcn_mfma_f32_32x32x16_bf16(pa3, PK(3), o[d0], 0, 0, 0);
#undef PK
    }
}
__device__ __forceinline__ float dpp_shl(float v, int) { return v; }
#define DPP_SHL(v, n) __builtin_bit_cast(float, __builtin_amdgcn_update_dpp(0, __builtin_bit_cast(int, (v)), 0x100 | (n), 0xF, 0xF, true))
__device__ __forceinline__ float suffix_incl(float v, int lane) {
    v += DPP_SHL(v, 1); v += DPP_SHL(v, 2); v += DPP_SHL(v, 4); v += DPP_SHL(v, 8);
    const float t1 = __builtin_bit_cast(float, __builtin_amdgcn_readlane(__builtin_bit_cast(int, v), 16)), t2 = __builtin_bit_cast(float, __builtin_amdgcn_readlane(__builtin_bit_cast(int, v), 32)),
                t3 = __builtin_bit_cast(float, __builtin_amdgcn_readlane(__builtin_bit_cast(int, v), 48));
    const int row = lane >> 4;
    const float add = (row == 0) ? (t1 + t2) + t3 : (row == 1) ? t2 + t3 : (row == 2) ? t3 : 0.f;
    return v + add;
}
__device__ __forceinline__ float lane0(float v) { return __builtin_bit_cast(float, __builtin_amdgcn_readfirstlane(__builtin_bit_cast(int, v))); }
template <bool BAND>
__device__ __forceinline__ void tile_body(f32x16* o, float& l_reg, const bf16x8* qr, const LAS unsigned char* kbs, const LAS float* wb, int vb, float ci, int hi, int keybase, int qabs) {
    f32x16 p0, p1;
#pragma unroll
    for (int g4 = 0; g4 < 4; ++g4) {
        const f32x4 ba = *(const LAS f32x4*)(wb + 8 * g4 + 4 * hi) + ci, bb = *(const LAS f32x4*)(wb + 32 + 8 * g4 + 4 * hi) + ci;
#pragma unroll
        for (int e = 0; e < 4; ++e) { p0[4 * g4 + e] = ba[e]; p1[4 * g4 + e] = bb[e]; }
    }
#pragma unroll
    for (int d0 = 0; d0 < 4; ++d0) {
        const bf16x8 b0 = *(const LAS bf16x8*)(kbs + d0 * 2048), b1 = *(const LAS bf16x8*)(kbs + d0 * 2048 + 512);
        p0 = __builtin_amdgcn_mfma_f32_32x32x16_bf16(b0, qr[d0], p0, 0, 0, 0); p1 = __builtin_amdgcn_mfma_f32_32x32x16_bf16(b1, qr[d0], p1, 0, 0, 0); }
    if (BAND) {
#pragma unroll
        for (int r = 0; r < 16; ++r) { const int key = keybase + 8 * (r >> 2) + (r & 3); if (key > qabs) p0[r] = -INFINITY; if (key + 32 > qabs) p1[r] = -INFINITY; }
    }
    f32x2 s2 = {0.f, 0.f};
#pragma unroll
    for (int r = 0; r < 16; r += 2) {
        p0[r] = __builtin_amdgcn_exp2f(p0[r]); p0[r + 1] = __builtin_amdgcn_exp2f(p0[r + 1]); p1[r] = __builtin_amdgcn_exp2f(p1[r]); p1[r + 1] = __builtin_amdgcn_exp2f(p1[r + 1]);
        s2 += (f32x2){p0[r], p0[r + 1]}; s2 += (f32x2){p1[r], p1[r + 1]}; }
    l_reg += s2.x + s2.y;
    u32x4 pw0, pw1, pw2, pw3;
    pw0 = (u32x4){cvtpk(p0[0], p0[1]), cvtpk(p0[2], p0[3]), cvtpk(p0[4], p0[5]), cvtpk(p0[6], p0[7])};
    pw1 = (u32x4){cvtpk(p0[8], p0[9]), cvtpk(p0[10], p0[11]), cvtpk(p0[12], p0[13]), cvtpk(p0[14], p0[15])};
    pw2 = (u32x4){cvtpk(p1[0], p1[1]), cvtpk(p1[2], p1[3]), cvtpk(p1[4], p1[5]), cvtpk(p1[6], p1[7])};
    pw3 = (u32x4){cvtpk(p1[8], p1[9]), cvtpk(p1[10], p1[11]), cvtpk(p1[12], p1[13]), cvtpk(p1[14], p1[15])};
    pv(o, vb, __builtin_bit_cast(bf16x8, pw0), __builtin_bit_cast(bf16x8, pw1), __builtin_bit_cast(bf16x8, pw2), __builtin_bit_cast(bf16x8, pw3));
}
#ifndef ATT_SKIP
#define ATT_SKIP 1
#endif
__device__ __forceinline__ void attn_unit(const UnitDesc& u, LAS unsigned char* shm, float qkmax, float thresh) {
    int tid_ = threadIdx.x; asm volatile("" : "+v"(tid_));
    const int tid = tid_, lane = tid & 63, r32 = lane & 31, hi = lane >> 5; const int wid = __builtin_amdgcn_readfirstlane(tid >> 6);
    const int NT = (u.q0 + u.nq) >> 6, nband = u.nq >> 6;
    const bool active = wid * 32 < u.nq;
    LAS float* wsf = (LAS float*)(shm + LDS_WS) + wid * 128;
    const bf16_t* ksrc = u.K + (size_t)lane * 512 + wid * 8;
    const bf16_t* vsrc = u.V + (size_t)(16 * (wid & 3) + (lane >> 2)) * 512 + (wid >> 2) * 32 + (lane & 3) * 8;
    const float* lsrc = u.LF + (size_t)lane * 8;
    LAS unsigned char* kdst = shm + LDS_K + wid * 1024 + lane * 16;
    LAS unsigned char* vdst = shm + LDS_V + wid * 1024 + lane * 16;
    const int vb0 = (int)(unsigned)(uintptr_t)(shm + LDS_V) + ((lane >> 4) & 1) * 32 + (lane & 3) * 8 + (4 * hi + ((lane & 15) >> 2)) * 64;
    const LAS unsigned char* kb = shm + LDS_K + hi * 1024 + r32 * 16;
#define ATT_GLD16(dst, ptr) asm volatile("global_load_dwordx4 %0, %1, off" : "=&v"(dst) : "v"(ptr) : "memory")
#define ATT_GLD4(dst, ptr)  asm volatile("global_load_dword %0, %1, off" : "=&v"(dst) : "v"(ptr) : "memory")
    u32x4 kreg = *(const u32x4*)(ksrc + (size_t)(NT - 1) * 64 * 512), vreg = *(const u32x4*)(vsrc + (size_t)(NT - 1) * 64 * 512);
    float lfb[4];
#pragma unroll
    for (int jb = 0; jb < 4; ++jb) { const int tile = NT - 1 - jb; lfb[jb] = lsrc[(size_t)(tile > 0 ? tile : 0) * 64 * 8]; }
    u32x4 kA, vA, kB, vB, kC, vC;
    { const int t2 = NT >= 2 ? NT - 2 : 0, t3 = NT >= 3 ? NT - 3 : 0, t4 = NT >= 4 ? NT - 4 : 0;
      ATT_GLD16(kA, ksrc + (size_t)t2 * 64 * 512); ATT_GLD16(vA, vsrc + (size_t)t2 * 64 * 512);
      ATT_GLD16(kB, ksrc + (size_t)t3 * 64 * 512); ATT_GLD16(vB, vsrc + (size_t)t3 * 64 * 512);
      ATT_GLD16(kC, ksrc + (size_t)t4 * 64 * 512); ATT_GLD16(vC, vsrc + (size_t)t4 * 64 * 512); }
    bf16x8 qr[4];
#pragma unroll
    for (int d0 = 0; d0 < 4; ++d0) qr[d0] = (bf16x8){0, 0, 0, 0, 0, 0, 0, 0};
    if (active) { const bf16_t* Qw = u.Q + (size_t)(wid * 32 + r32) * 512;
#pragma unroll
        for (int d0 = 0; d0 < 4; ++d0) qr[d0] = *(const bf16x8*)(Qw + d0 * 16 + hi * 8); }
    float carry = 0.f, Rown = 0.f, Rq0 = 0.f, inc4[4];
#pragma unroll
    for (int i = 0; i < 4; ++i) inc4[i] = suffix_incl(lfb[i], lane);
#pragma unroll
    for (int i = 0; i < 4; ++i) { if (i < nband) { const int jb = nband - 1 - i; const float R = carry + inc4[i] - lfb[i];
        const float ro = __shfl(R, 32 * (wid & 1) + r32); if (jb == (wid >> 1)) Rown = ro;
        if (jb == 0) Rq0 = __shfl(R, 0);
        carry += lane0(inc4[i]); } }
    const float ci = -Rown * LOG2E - qkmax;
    const float kbq0 = Rq0 * LOG2E;
    const int qabs = u.q0 + wid * 32 + r32;
    float l_reg = 0.f; f32x16 o[2]; o[0] = f32x16{}; o[1] = f32x16{};
    float lA = lfb[1], lB = lfb[2], lC = lfb[3];
    { const float lf = lfb[0]; const float inc = inc4[0]; wsf[lane] = (inc - lf) * LOG2E; carry = lane0(inc);
      *(LAS u32x4*)kdst = kreg; *(LAS u32x4*)vdst = vreg;
      asm volatile("" : "+v"(qr[0]), "+v"(qr[1]), "+v"(qr[2]), "+v"(qr[3]));
      asm volatile("s_waitcnt vmcnt(0)" : "+v"(kA), "+v"(vA), "+v"(kB), "+v"(vB), "+v"(kC), "+v"(vC) :: "memory"); }
    int slot = 0, tile = NT - 1; bool stop = false;
#define ATT_ITER(KR, VR, LR) do { \
        const float carry_t = carry;                         \
        asm volatile("s_waitcnt lgkmcnt(0)\n\ts_barrier" ::: "memory"); \
        asm volatile("s_waitcnt vmcnt(6)" : "+v"(KR), "+v"(VR), "+v"(LR) :: "memory"); \
        { const float lf = LR; const float inc = suffix_incl(lf, lane); \
          wsf[(slot ^ 1) * 64 + lane] = (carry + inc - lf) * LOG2E; carry += lane0(inc); \
          *(LAS u32x4*)(kdst + (slot ^ 1) * 16384) = KR; *(LAS u32x4*)(vdst + (slot ^ 1) * 16384) = VR; \
          asm volatile("s_waitcnt lgkmcnt(0)" ::: "memory");                     \
          const int tn = tile >= 4 ? tile - 4 : 0; \
          ATT_GLD4(LR, lsrc + (size_t)tn * 64 * 8); ATT_GLD16(KR, ksrc + (size_t)tn * 64 * 512); ATT_GLD16(VR, vsrc + (size_t)tn * 64 * 512); } \
        if (active) { \
            if (tile * 64 > u.q0 + wid * 32 + 31) {   } \
            else if (tile >= NT - nband) tile_body<true>(o, l_reg, qr, kb + slot * 16384, wsf + slot * 64, vb0 + slot * 16384, ci, hi, tile * 64 + 4 * hi, qabs); \
            else tile_body<false>(o, l_reg, qr, kb + slot * 16384, wsf + slot * 64, vb0 + slot * 16384, ci, hi, tile * 64 + 4 * hi, qabs); \
        } \
        slot ^= 1; \
        stop = (tile == 0) || (ATT_SKIP && (carry_t * LOG2E - kbq0 < -thresh));     \
        --tile; } while (0)
    for (;;) {
        ATT_ITER(kA, vA, lA); if (stop) break;
        ATT_ITER(kB, vB, lB); if (stop) break;
        ATT_ITER(kC, vC, lC); if (stop) break;
    }
#undef ATT_ITER
    asm volatile("s_waitcnt vmcnt(0)" : "+v"(kA), "+v"(vA), "+v"(kB), "+v"(vB), "+v"(kC), "+v"(vC), "+v"(lA), "+v"(lB), "+v"(lC) :: "memory");
    if (active) {
        u32x4 zv4[4];
#pragma unroll
        for (int i = 0; i < 4; ++i) zv4[i] = *(const u32x4*)(u.Zg + (size_t)(wid * 32 + i * 8 + (lane >> 3)) * 512 + (lane & 7) * 8);
        { auto rr = __builtin_amdgcn_permlane32_swap(__float_as_uint(l_reg), __float_as_uint(l_reg), false, false); l_reg = __uint_as_float(rr[0]) + __uint_as_float(rr[1]); }
        LAS float* lx = (LAS float*)(shm + LDS_LX) + wid * 32;
        if (hi == 0) lx[r32] = l_reg;
        asm volatile("s_waitcnt lgkmcnt(0)" ::: "memory");
        float rli[16];
#pragma unroll
        for (int r = 0; r < 16; ++r) rli[r] = 1.f / lx[crow(r, hi)];
        LAS bf16_t* stg = (LAS bf16_t*)(shm + LDS_OST) + wid * 2048;
#pragma unroll
        for (int r = 0; r < 16; ++r) { const int orow = crow(r, hi);
#pragma unroll
            for (int d0 = 0; d0 < 2; ++d0) stg[orow * 64 + d0 * 32 + r32] = (bf16_t)f2bf(o[d0][r] * rli[r]); }
        asm volatile("s_waitcnt lgkmcnt(0)" ::: "memory");
#pragma unroll
        for (int i = 0; i < 4; ++i) { const int row = i * 8 + (lane >> 3), ch = lane & 7;
            const u32x4 ov = *(const LAS u32x4*)(stg + row * 64 + ch * 8);
            const u32x4 zv = zv4[i];
            u32x4 w; w.x = pk2(bflo(ov.x) * bflo(zv.x), bfhi(ov.x) * bfhi(zv.x)); w.y = pk2(bflo(ov.y) * bflo(zv.y), bfhi(ov.y) * bfhi(zv.y));
            w.z = pk2(bflo(ov.z) * bflo(zv.z), bfhi(ov.z) * bfhi(zv.z)); w.w = pk2(bflo(ov.w) * bflo(zv.w), bfhi(ov.w) * bfhi(zv.w));
            *(u32x4*)(u.O + (size_t)(wid * 32 + row) * 1024 + ch * 8) = w; }
    }
}
}


#define XB_TMO      128
#define XB_XCNT(j)  (256  + 64 * (j))
#define XB_XSUB(j)  (1280 + 64 * (j))
#define XB_XGEN(j)  (2304 + 64 * (j))
#define XB_TOP      3328
#define XB_TOPGEN   3392
#define XCD_BAR_WORDS 3456
#define XB_SPIN_CAP (1u << 18)
__device__ __forceinline__ unsigned xb_ld(unsigned* p)              { return __hip_atomic_load(p, __ATOMIC_RELAXED, __HIP_MEMORY_SCOPE_AGENT); }
__device__ __forceinline__ unsigned xb_add(unsigned* p, unsigned v) { return __hip_atomic_fetch_add(p, v, __ATOMIC_RELAXED, __HIP_MEMORY_SCOPE_AGENT); }
__device__ __forceinline__ unsigned xb_xcc_id() { return (unsigned)__builtin_amdgcn_s_getreg((3 << 11) | 20) & 0xFu; }
#define XB_SPIN(cond, bar) do { unsigned _sp = 0; while (cond) { __builtin_amdgcn_s_sleep(1); \
    if ((++_sp & 255u) == 0u) { if (xb_ld(&(bar)[XB_TMO])) break; if (_sp > XB_SPIN_CAP) { atomicAdd(&(bar)[XB_TMO], 1u); break; } } } } while (0)
struct XcdBarrier { unsigned* bar; unsigned x; volatile LAS unsigned* st; };
__device__ __forceinline__ XcdBarrier xcd_barrier_post(unsigned* bar, volatile LAS unsigned* st) {
    XcdBarrier b; b.bar = bar; b.x = xb_xcc_id(); b.st = st;
    if (threadIdx.x == 0) (void)xb_add(&bar[XB_XCNT(b.x)], 1u);
    return b;
}
__device__ __forceinline__ void xcd_barrier_complete(unsigned* bar, unsigned x, unsigned& nloc, unsigned& nx) {
    const unsigned G = gridDim.x * gridDim.y * gridDim.z;
    unsigned sum, cnt, mine, sp = 0u;
    for (;;) {
        sum = 0u; cnt = 0u; mine = 0u;
#pragma unroll
        for (unsigned j = 0; j < 16; ++j) { const unsigned c = xb_ld(&bar[XB_XCNT(j)]); sum += c; cnt += (c > 0u) ? 1u : 0u; mine = (j == x) ? c : mine; }
        if (sum == G) break;
        __builtin_amdgcn_s_sleep(1);
        if ((++sp & 255u) == 0u) { if (xb_ld(&bar[XB_TMO])) break; if (sp > XB_SPIN_CAP) { atomicAdd(&bar[XB_TMO], 1u); break; } }
    }
    nloc = mine > 0u ? mine : 1u; nx = cnt > 0u ? cnt : 1u;
}
__device__ __forceinline__ void xcd_barrier(const XcdBarrier& b) {
    asm volatile("s_waitcnt vmcnt(0)" ::: "memory");
    __syncthreads();
    if (threadIdx.x == 0) {
        unsigned* bar = b.bar;
        __builtin_amdgcn_s_waitcnt(0);
        unsigned nloc = b.st[0], nx = b.st[1];
        if (nloc == 0u) { xcd_barrier_complete(bar, b.x, nloc, nx); b.st[0] = nloc; b.st[1] = nx; }
        const unsigned old = xb_add(&bar[XB_XSUB(b.x)], 1u);
        const unsigned gen = old / nloc;
        if (old + 1u == (gen + 1u) * nloc) {
            __builtin_amdgcn_fence(__ATOMIC_RELEASE, "agent");
            asm volatile("s_waitcnt vmcnt(0)" ::: "memory");
            const unsigned og = xb_add(&bar[XB_TOP], 1u);
            const unsigned tg = og / nx;
            if (og + 1u == (tg + 1u) * nx) xb_add(&bar[XB_TOPGEN], 1u);
            else XB_SPIN(xb_ld(&bar[XB_TOPGEN]) == tg, bar);
            __builtin_amdgcn_fence(__ATOMIC_ACQUIRE, "agent");
            xb_add(&bar[XB_XGEN(b.x)], 1u);
            asm volatile("s_waitcnt vmcnt(0)" ::: "memory");
        } else {
            XB_SPIN(xb_ld(&bar[XB_XGEN(b.x)]) == gen, bar);
            __builtin_amdgcn_fence(__ATOMIC_ACQUIRE, "agent");
            asm volatile("s_waitcnt vmcnt(0)" ::: "memory");
        }
    }
    __syncthreads();
}

__device__ __forceinline__ float wave_sum(float v) {
#pragma unroll
    for (int o = 1; o < 64; o <<= 1) v += __shfl_xor(v, o);
    return v;
}
template <bool HPERM>
__device__ __forceinline__ void p0_transpose_item(const float* W, int K, int N, int ldw, bf16_t* WT, LAS float* scr, int item, int lane) {
    const int nblk = N / 32, kb = item / nblk, nb = item % nblk, k0 = 64 * kb, n0 = 32 * nb;
#pragma unroll
    for (int i = 0; i < 32; ++i) { const int kk = 2 * i + (lane >> 5); scr[kk * 33 + (lane & 31)] = W[(size_t)(k0 + kk) * ldw + n0 + (lane & 31)]; }
    asm volatile("s_waitcnt lgkmcnt(0)" ::: "memory");
    int r0 = n0;
    if (HPERM) { const int o = n0 & 255, wc = o >> 6, bj = (o >> 5) & 1; r0 = (n0 & ~255) + 128 * bj + 32 * wc; }
    const int c = lane & 7;
#pragma unroll
    for (int j = 0; j < 4; ++j) { const int n = (lane >> 3) + 8 * j; const LAS float* s = scr + (8 * c) * 33 + n;
        u32x4 o; o.x = pk2(s[0 * 33], s[1 * 33]); o.y = pk2(s[2 * 33], s[3 * 33]); o.z = pk2(s[4 * 33], s[5 * 33]); o.w = pk2(s[6 * 33], s[7 * 33]);
        *(u32x4*)(WT + (size_t)(r0 + n) * K + k0 + 8 * c) = o; }
    asm volatile("s_waitcnt lgkmcnt(0)" ::: "memory");
}
__device__ __forceinline__ int fresh_tid() { int t = threadIdx.x; asm volatile("" : "+v"(t)); return t; }
#define TIDS() const int tid = fresh_tid(), lane = tid & 63, wave = __builtin_amdgcn_readfirstlane(tid >> 6); (void)lane; (void)wave
__device__ __forceinline__ f32x2 cmul(f32x2 a, f32x2 b) { return (f32x2){a.x * b.x - a.y * b.y, a.x * b.y + a.y * b.x}; }


template <class BRow>
__device__ __forceinline__ void skinny32(LAS float* Cs, const bf16_t* A, int lda, const bf16_t* Bt, int ldb, int NC, int K, const BRow& brow) {
    const int tid = fresh_tid(), lane = tid & 63, wave = __builtin_amdgcn_readfirstlane(tid >> 6), fr = lane & 15, fq = lane >> 4;
    const int nct = NC >> 4, ldc = NC + 4;
    for (int ct = wave; ct < nct; ct += NWAVES) {
        f32x4 acc0 = {0.f, 0.f, 0.f, 0.f}, acc1 = acc0;
        const bf16_t* ap = A + (size_t)fr * lda + fq * 8; const bf16_t* bp = Bt + (size_t)(brow(ct) + fr) * ldb + fq * 8;
        bf16x8 a0[8], a1[8], b[8];
#pragma unroll
        for (int i = 0; i < 8; ++i) { a0[i] = *(const bf16x8*)(ap + 32 * i); a1[i] = *(const bf16x8*)(ap + (size_t)16 * lda + 32 * i); b[i] = *(const bf16x8*)(bp + 32 * i); }
#pragma unroll 1
        for (int k0 = 0; k0 < K; k0 += 256) {
            bf16x8 n0[8], n1[8], nb[8];
            const int kn = (k0 + 256 < K) ? k0 + 256 : k0;
#pragma unroll
            for (int i = 0; i < 8; ++i) { n0[i] = *(const bf16x8*)(ap + kn + 32 * i); n1[i] = *(const bf16x8*)(ap + (size_t)16 * lda + kn + 32 * i); nb[i] = *(const bf16x8*)(bp + kn + 32 * i); }
#pragma unroll
            for (int i = 0; i < 8; ++i) { acc0 = __builtin_amdgcn_mfma_f32_16x16x32_bf16(b[i], a0[i], acc0, 0, 0, 0); acc1 = __builtin_amdgcn_mfma_f32_16x16x32_bf16(b[i], a1[i], acc1, 0, 0, 0); }
#pragma unroll
            for (int i = 0; i < 8; ++i) { a0[i] = n0[i]; a1[i] = n1[i]; b[i] = nb[i]; }
        }
        *(LAS f32x4*)(Cs + fr * ldc + ct * 16 + 4 * fq) = acc0; *(LAS f32x4*)(Cs + (16 + fr) * ldc + ct * 16 + 4 * fq) = acc1;
    }
    __syncthreads();
}

#define WSP(T, off) ((T*)(P.ws + (off)))
#define MOD WSP(float, WS_MOD)
#define A16 WSP(f32x2, WS_A16)
#define ABAR WSP(f32x2, WS_ABAR)
#define BBAR WSP(f32x2, WS_BBAR)
#define WIN WSP(bf16_t, WS_WIN)
#define WGLU WSP(bf16_t, WS_WGLU)
#define WOUT WSP(bf16_t, WS_WOUT)
#define W1 WSP(bf16_t, WS_W1)
#define W2 WSP(bf16_t, WS_W2)
#define XN WSP(bf16_t, WS_XN)
#define MX WSP(bf16_t, WS_XN)
#define UX WSP(bf16_t, WS_UX)
#define ZS WSP(bf16_t, WS_ZS)
#define QB WSP(bf16_t, WS_Q)
#define ZA WSP(bf16_t, WS_ZA)
#define KB WSP(bf16_t, WS_KB)
#define VB WSP(bf16_t, WS_VB)
#define KS WSP(bf16_t, WS_KS)
#define VS WSP(bf16_t, WS_VS)
#define LFS WSP(float, WS_LFS)
#define SB WSP(float, WS_SB)
#define YS WSP(bf16_t, WS_YS)
#define YSS WSP(bf16_t, WS_YSS)
#define CTL WSP(unsigned, WS_CTL)
__global__ void __launch_bounds__(NTHR, 2) hymba_fwd(Params P) {
    extern __shared__ __attribute__((aligned(16))) unsigned char lds_raw[];
    cg::grid_group grid = cg::this_grid();
    LAS unsigned char* lds = (LAS unsigned char*)lds_raw;
    const int G = gridDim.x, blk = blockIdx.x;
    float* out = P.out;
    if (threadIdx.x < 32) ((LAS unsigned*)(lds + MISC_OFF))[threadIdx.x] = 0u;
    __syncthreads();
    const XcdBarrier xbar = xcd_barrier_post(CTL + 4096, (volatile LAS unsigned*)(lds + MISC_OFF) + 8);
#define GRID_BAR() xcd_barrier(xbar)

    for (int rep0 = 0; rep0 < REP_P0; ++rep0) {
    for (int it = blk; it < 48 + NG; it += G) {
        TIDS();
        if (it < 48) {
            LAS float* sil = (LAS float*)(lds + wave * 16384);
            LAS float* red = (LAS float*)(lds + wave * 16384 + 8192);
            for (int idx = lane; idx < 2048; idx += 64) { const int kk = idx >> 4, b = idx & 15, k = wave * 128 + kk;
                const float c = (b < 8) ? P.c_prompt[b * DM + k] : P.c_sample[(b - 8) * DM + k]; sil[idx] = siluf_(c); }
            asm volatile("s_waitcnt lgkmcnt(0)" ::: "memory");
            const int col = it * 64 + lane;
            float acc[16];
#pragma unroll
            for (int b = 0; b < 16; ++b) acc[b] = 0.f;
#pragma unroll 32
            for (int kk = 0; kk < 128; ++kk) { const float wv = P.w_ada[(size_t)(wave * 128 + kk) * 3072 + col];
#pragma unroll
                for (int q = 0; q < 4; ++q) { const f32x4 s = *(const LAS f32x4*)(sil + kk * 16 + 4 * q); acc[4 * q] += s[0] * wv; acc[4 * q + 1] += s[1] * wv; acc[4 * q + 2] += s[2] * wv; acc[4 * q + 3] += s[3] * wv; } }
#pragma unroll
            for (int b = 0; b < 16; ++b) red[b * 64 + lane] = acc[b];
            __syncthreads();
#pragma unroll
            for (int bb = 0; bb < 2; ++bb) { const int b = wave * 2 + bb; float s = P.b_ada[col];
#pragma unroll
                for (int w = 0; w < 8; ++w) s += *((LAS float*)(lds + w * 16384 + 8192) + b * 64 + lane);
                MOD[b * 3072 + col] = s; }
            __syncthreads();
        } else {
            const int g = it - 48;
            LAS f32x2* PW = (LAS f32x2*)lds;
            LAS f32x2* BBl = (LAS f32x2*)(lds + 8704);
            LAS f32x2* CCl = (LAS f32x2*)(lds + 16896);
            LAS float* KT = (LAS float*)(lds + 25088);
            if (tid < 64) { const int n = tid; const float dt = expf(P.log_dt[g]); const float are = P.a_re[g * 64 + n], aim = P.a_im[g * 64 + n];
                const float mag = expf(are * dt), ang = aim * dt; float sn, cs; sincosf(ang, &sn, &cs);
                const f32x2 ab = {mag * cs, mag * sn};
                const float den = are * are + aim * aim, nre = ab.x - 1.f, nim = ab.y;
                const f32x2 q = {(nre * are + nim * aim) / den, (nim * are - nre * aim) / den};
                f32x2 pw = {1.f, 0.f};
                for (int j = 0; j <= 16; ++j) { PW[j * 64 + n] = pw; pw = cmul(pw, ab); }
                ABAR[g * 64 + n] = ab; A16[g * 64 + n] = PW[16 * 64 + n];
                f32x4 brv[4], biv[4];
#pragma unroll
                for (int p4 = 0; p4 < 4; ++p4) { brv[p4] = *(const f32x4*)(P.b_re + (g * 64 + n) * 16 + 4 * p4); biv[p4] = *(const f32x4*)(P.b_im + (g * 64 + n) * 16 + 4 * p4); }
#pragma unroll
                for (int p = 0; p < 16; ++p) { const f32x2 bb = {brv[p >> 2][p & 3], biv[p >> 2][p & 3]}; const f32x2 v = cmul(q, bb); BBl[n * 16 + p] = v; BBAR[(g * 64 + n) * 16 + p] = v; } }
            for (int idx = tid; idx < 1024; idx += NTHR) CCl[idx] = (f32x2){P.c_re[g * 1024 + idx], P.c_im[g * 1024 + idx]};
            __syncthreads();
            for (int idx = tid; idx < 4096; idx += NTHR) { const int d = idx >> 8, p = (idx >> 4) & 15, pp = idx & 15; float s = 0.f;
                for (int n = 0; n < 64; ++n) { const f32x2 t = cmul(CCl[p * 64 + n], PW[d * 64 + n]); const f32x2 b = BBl[n * 16 + pp]; s += t.x * b.x - t.y * b.y; }
                if (d == 0 && p == pp) s += P.d_skip[g * 16 + p];
                KT[idx] = s; }
            __syncthreads();
            bf16_t* w2 = W2 + (size_t)g * 256 * 384;
            for (int idx = tid; idx < 256 * 192; idx += NTHR) { const int c = idx / 192, k = (idx % 192) * 2, t = c >> 4, p = c & 15; float v[2];
#pragma unroll
                for (int e = 0; e < 2; ++e) { const int kk = k + e; float r;
                    if (kk < 256) { const int s = kk >> 4, pp = kk & 15; r = (s <= t) ? KT[((t - s) * 16 + p) * 16 + pp] : 0.f; }
                    else { const int n = (kk - 256) & 63; const f32x2 z = cmul(CCl[p * 64 + n], PW[(t + 1) * 64 + n]); r = (kk < 320) ? z.x : -z.y; }
                    v[e] = r; }
                *(unsigned*)(w2 + (size_t)c * 384 + k) = pk2(v[0], v[1]); }
            bf16_t* w1 = W1 + (size_t)g * 256 * 256;
            for (int idx = tid; idx < 256 * 128; idx += NTHR) { const int np = idx >> 7, k = (idx & 127) * 2; float v[2];
#pragma unroll
                for (int e = 0; e < 2; ++e) { const int kk = k + e, s = kk >> 4, pp = kk & 15; float r = 0.f;
                    if (np < 128) { const int n = np & 63; const f32x2 z = cmul(PW[(15 - s) * 64 + n], BBl[n * 16 + pp]); r = (np < 64) ? z.x : z.y; }
                    v[e] = r; }
                *(unsigned*)(w1 + (size_t)np * 256 + k) = pk2(v[0], v[1]); }
            __syncthreads();
        }
    }
    {
        TIDS();
        LAS float* scr = (LAS float*)(lds + wave * 16384);
        const bool spare = G > 2 * (48 + NG);
        const int bq = spare ? blk - (48 + NG) : blk, Gq = spare ? G - (48 + NG) : G;
        const int gw = bq * NWAVES + wave, NGW = Gq * NWAVES;
        constexpr int I_IN = (DM / 64) * (NPROJ / 32), I_GLU = (SW / 64) * (SW / 32), I_OUT = (DM / 64) * (DM / 32);
        for (int it = (bq >= 0 ? gw : 0x7fffffff - NGW); it < I_IN + I_GLU + I_OUT; it += NGW) {
            int r = it;
            if (r < I_IN) { p0_transpose_item<true>(P.w_in, DM, NPROJ, INW, WIN, scr, r, lane); continue; } r -= I_IN;
            if (r < I_GLU) { p0_transpose_item<false>(P.w_glu, SW, SW, SW, WGLU, scr, r, lane); continue; } r -= I_GLU;
            p0_transpose_item<false>(P.w_out, DM, DM, DM, WOUT, scr, r, lane);
        }
        const int gt = (bq >= 0) ? bq * NTHR + tid : 0x7fffffff - Gq * NTHR, NGT = Gq * NTHR;
#pragma unroll 4
        for (int i = gt; i < NB * PAST * 64; i += NGT) { const int row = i >> 6, ch = i & 63, b = row >> 11, j = row & 2047;
            const f32x4 k0 = *(const f32x4*)(P.cache_k + (size_t)row * 512 + ch * 8), k1 = *(const f32x4*)(P.cache_k + (size_t)row * 512 + ch * 8 + 4);
            const f32x4 v0 = *(const f32x4*)(P.cache_v + (size_t)row * 512 + ch * 8), v1 = *(const f32x4*)(P.cache_v + (size_t)row * 512 + ch * 8 + 4);
            *(u32x4*)(KS + (size_t)(b * SKV + j) * 512 + ch * 8) = (u32x4){pk2(k0[0], k0[1]), pk2(k0[2], k0[3]), pk2(k1[0], k1[1]), pk2(k1[2], k1[3])};
            *(u32x4*)(VS + (size_t)(b * SKV + j) * 512 + ch * 8) = (u32x4){pk2(v0[0], v0[1]), pk2(v0[2], v0[3]), pk2(v1[0], v1[1]), pk2(v1[2], v1[3])}; }
        for (int i = gt; i < NB * PAST * NH; i += NGT) { const int b = i / (PAST * NH), r = i % (PAST * NH); LFS[(size_t)b * SKV * NH + r] = P.cache_logf[i]; }
    }
    }
    if (G == 0x7fffffff) grid.sync();
    GRID_BAR();

    for (int rep = 0; rep < REP_P1; ++rep) {
        TIDS();
        __syncthreads();
        LAS float* w8 = (LAS float*)lds;
#pragma unroll
        for (int i0 = 0; i0 < 8192; i0 += NTHR) { const int i = i0 + tid, c = i >> 10, k = i & 1023; w8[i] = P.w_in[(size_t)k * INW + NPROJ + c]; }
        __syncthreads();
        const int gw = blk * NWAVES + wave, NGW = G * NWAVES;
        constexpr int NPAIR = MT / 2; const int per = (NPAIR + NGW - 1) / NGW;
        const int p_lo = gw * per, p_hi = (p_lo + per < NPAIR) ? p_lo + per : NPAIR;
        int cur_b = -1; f32x4 Ak[4], Bk[4]; float bsel = 0.f;
        for (int j = 0; j < 4; ++j) { Ak[j] = (f32x4){0.f, 0.f, 0.f, 0.f}; Bk[j] = Ak[j]; }
        f32x4 x0[4], x1[4];
        auto rowptr = [&](int m) -> const float* { return (m < PT) ? P.x_prompt + (size_t)m * DM : P.x_sample + (size_t)(m - PT) * DM; };
        if (p_lo < p_hi) { const float* r0 = rowptr(2 * p_lo); const float* r1 = rowptr(2 * p_lo + 1);
#pragma unroll
            for (int j = 0; j < 4; ++j) { x0[j] = *((const f32x4*)r0 + lane + 64 * j); x1[j] = *((const f32x4*)r1 + lane + 64 * j); } }
        for (int p = p_lo; p < p_hi; ++p) {
            const int m0 = 2 * p;
            const int bidx = (m0 < PT) ? (m0 >> 13) : 8 + ((m0 - PT) >> 6);
            if (bidx != cur_b) {
                cur_b = bidx; const float* md = MOD + (size_t)bidx * 3072; float b2[8];
#pragma unroll
                for (int c = 0; c < 8; ++c) b2[c] = 0.f;
#pragma unroll
                for (int j = 0; j < 4; ++j) { const int k = 4 * lane + 256 * j;
                    const f32x4 gv = *(const f32x4*)(P.norm_g + k), sh = *(const f32x4*)(md + k), sc = *(const f32x4*)(md + 1024 + k);
                    Ak[j] = gv * (sc + 1.f); Bk[j] = sh;
#pragma unroll
                    for (int c = 0; c < 8; ++c) { const f32x4 w = *(const LAS f32x4*)(w8 + c * 1024 + k); b2[c] += (sh.x * w.x + sh.y * w.y) + (sh.z * w.z + sh.w * w.w); } }
#pragma unroll
                for (int c = 0; c < 8; ++c) b2[c] = wave_sum(b2[c]);
                bsel = b2[0];
#pragma unroll
                for (int c = 1; c < 8; ++c) bsel = (((lane >> 2) & 7) == c) ? b2[c] : bsel;
                bsel += P.b_f[(lane >> 2) & 7];
            }
            f32x4 n0[4], n1[4];
            { const int pn = (p + 1 < p_hi) ? p + 1 : p; const float* r0 = rowptr(2 * pn); const float* r1 = rowptr(2 * pn + 1);
#pragma unroll
              for (int j = 0; j < 4; ++j) { n0[j] = *((const f32x4*)r0 + lane + 64 * j); n1[j] = *((const f32x4*)r1 + lane + 64 * j); } }
            float ss0 = 0.f, ss1 = 0.f, v[16];
#pragma unroll
            for (int c = 0; c < 16; ++c) v[c] = 0.f;
#pragma unroll
            for (int j = 0; j < 4; ++j) { const int k = 4 * lane + 256 * j;
                ss0 += (x0[j].x * x0[j].x + x0[j].y * x0[j].y) + (x0[j].z * x0[j].z + x0[j].w * x0[j].w);
                ss1 += (x1[j].x * x1[j].x + x1[j].y * x1[j].y) + (x1[j].z * x1[j].z + x1[j].w * x1[j].w);
                x0[j] = x0[j] * Ak[j]; x1[j] = x1[j] * Ak[j];
#pragma unroll
                for (int c = 0; c < 8; ++c) { const f32x4 w = *(const LAS f32x4*)(w8 + c * 1024 + k);
                    v[c] += (x0[j].x * w.x + x0[j].y * w.y) + (x0[j].z * w.z + x0[j].w * w.w);
                    v[8 + c] += (x1[j].x * w.x + x1[j].y * w.y) + (x1[j].z * w.z + x1[j].w * w.w); }
                asm volatile("" ::: "memory"); }
            ss0 = wave_sum(ss0); ss1 = wave_sum(ss1);
#define P1_STEP(nn, mask) _Pragma("unroll") for (int i = 0; i < nn; ++i) { const bool up = (lane & mask) != 0; const float keep = up ? v[i + nn] : v[i], send = up ? v[i] : v[i + nn]; v[i] = keep + __shfl_xor(send, mask); }
            P1_STEP(8, 32) P1_STEP(4, 16) P1_STEP(2, 8) P1_STEP(1, 4)
#undef P1_STEP
            v[0] += __shfl_xor(v[0], 2); v[0] += __shfl_xor(v[0], 1);
            const float rs0 = rsqrtf(ss0 * (1.f / DM) + NORM_EPS), rs1 = rsqrtf(ss1 * (1.f / DM) + NORM_EPS);
#pragma unroll
            for (int j = 0; j < 4; ++j) { const f32x4 h0 = x0[j] * rs0 + Bk[j], h1 = x1[j] * rs1 + Bk[j];
                *((u32x2*)(XN + (size_t)m0 * DM) + lane + 64 * j) = (u32x2){pk2(h0.x, h0.y), pk2(h0.z, h0.w)};
                *((u32x2*)(XN + (size_t)(m0 + 1) * DM) + lane + 64 * j) = (u32x2){pk2(h1.x, h1.y), pk2(h1.z, h1.w)}; }
            if ((lane & 3) == 0) { const int r = lane >> 5, c = (lane >> 2) & 7, m = m0 + r;
                const float z = (r ? rs1 : rs0) * v[0] + bsel; const float lf = fminf(z, 0.f) - log1pf(__expf(-fabsf(z)));
                if (m < PT) out[O_LFP + (size_t)m * NH + c] = lf;
                else { const int sidx = m - PT, b = sidx >> 6, t = sidx & 63; out[O_LFS + (size_t)sidx * NH + c] = lf; LFS[(size_t)(b * SKV + PAST + t) * NH + c] = lf; } }
#pragma unroll
            for (int j = 0; j < 4; ++j) { x0[j] = n0[j]; x1[j] = n1[j]; }
        }
    }
    GRID_BAR();

    for (int rep = 0; rep < REP_P2; ++rep) {
        for (int it = blk; it < 256; it += G) {
            const int mb = it & 15, ns = it >> 4;
            LAS float* Cs = (LAS float*)lds; constexpr int ldc = 196;
            __syncthreads();
            skinny32(Cs, XN + (size_t)(PT + 32 * mb) * DM, DM, WIN, DM, 192, DM,
                     [&](int ct) { const int n = 192 * ns + 16 * ct, o = n & 255; return (n & ~255) + 128 * ((o >> 5) & 1) + 32 * (o >> 6) + (o & 31); });
            const int tid = fresh_tid();
#pragma unroll
            for (int ps = 0; ps < 2; ++ps) {
                const int task = tid + 512 * ps; const bool ok = task < 768; const int tk = ok ? task : 0;
                const int row = tk / 24, ch = tk % 24, n = 192 * ns + 8 * ch, type = n >> 9, cb = n & 511, d0 = n & 63;
                const f32x4 c0 = *(const LAS f32x4*)(Cs + row * ldc + 8 * ch), c1 = *(const LAS f32x4*)(Cs + row * ldc + 8 * ch + 4);
                float v[8] = {c0[0], c0[1], c0[2], c0[3], c1[0], c1[1], c1[2], c1[3]};
                float ss = 0.f;
#pragma unroll
                for (int e = 0; e < 8; ++e) ss += v[e] * v[e];
                ss += __shfl_xor(ss, 1); ss += __shfl_xor(ss, 2); ss += __shfl_xor(ss, 4);
                if (ok) {
                    const int sidx = 32 * mb + row, m = PT + sidx, b = sidx >> 6, t = sidx & 63;
                    if (type == 2 || type == 3) { const float rs = rsqrtf(ss * (1.f / 64.f) + NORM_EPS); const float* gp = (type == 2) ? P.q_g : P.k_g;
#pragma unroll
                        for (int e = 0; e < 8; ++e) v[e] = v[e] * rs * gp[d0 + e] * (type == 2 ? C2 : 1.f); }
                    else if (type == 1 || type == 5) {
#pragma unroll
                        for (int e = 0; e < 8; ++e) v[e] = siluf_(v[e]); }
                    bf16_t* bdst; float* fdst = nullptr;
                    if (type == 0) bdst = UX + ux_off(m, cb);
                    else if (type == 1) bdst = ZS + (size_t)m * 512;
                    else if (type == 2) bdst = QB + (size_t)m * 512;
                    else if (type == 5) bdst = ZA + (size_t)m * 512;
                    else { bdst = (type == 3 ? KS : VS) + (size_t)(b * SKV + PAST + t) * 512; fdst = out + (type == 3 ? O_KS : O_VS) + (size_t)sidx * 512; }
                    *(u32x4*)(bdst + (type == 0 ? 0 : cb)) = (u32x4){pk2(v[0], v[1]), pk2(v[2], v[3]), pk2(v[4], v[5]), pk2(v[6], v[7])};
                    if (fdst) { *(f32x4*)(fdst + cb) = (f32x4){v[0], v[1], v[2], v[3]}; *(f32x4*)(fdst + cb + 4) = (f32x4){v[4], v[5], v[6], v[7]}; }
                }
            }
            __syncthreads();
        }
        pg8::Gemm g{DM * 2, DM * 2, 128, 128, DM / 64, 0}; pg8::StaticOrder S; S.init(PT, NPROJ, G, blk, XN, WIN, DM * 2, DM * 2);
        EpiInProj E{UX, ZS, QB, ZA, KB, VB, KS, VS, out + O_KP, out + O_VP, out + O_KS, out + O_VS, P.q_g, P.k_g};
        pg8::gemm_phase<EpiInProj, pg8::StaticOrder>(lds, g, S, E);
    }
    GRID_BAR();

    for (int rep3 = 0; rep3 < REP_P3; ++rep3) {
    __syncthreads();
    {
        pg8::Gemm g{UXR * 32, 256 * 2, 128, 128, 4, 0}; pg8::S5Order S{G, blk, (const char*)UX, (const char*)W1, (size_t)256 * 256 * 2};
        EpiS E{SB};
        pg8::gemm_phase<EpiS, pg8::S5Order>(lds, g, S, E);
    }
    __syncthreads();
    for (int it = blk; it < NB * NG; it += G) {
        TIDS();
        const int b = it >> 5, g = it & 31;
        LAS f32x2* XS = (LAS f32x2*)lds;
        LAS float* US = (LAS float*)(lds + 33280);
        LAS float* CR = (LAS float*)(lds + 37376);
        LAS float* CI = (LAS float*)(lds + 41536);
        for (int i = tid; i < 1024; i += NTHR) { const int t = i >> 4, p = i & 15, s = b * 64 + t; US[i] = bf2f(UX[ux_off(PT + s, g * 16 + p)]);
            CR[(i >> 6) * 65 + (i & 63)] = P.c_re[g * 1024 + i]; CI[(i >> 6) * 65 + (i & 63)] = P.c_im[g * 1024 + i]; }
        __syncthreads();
        { const int n = lane; f32x2 bb[16];
#pragma unroll
          for (int p = 0; p < 16; ++p) bb[p] = BBAR[(g * 64 + n) * 16 + p];
#pragma unroll
          for (int tt = 0; tt < 8; ++tt) { const int t = wave * 8 + tt; f32x2 bu = {0.f, 0.f};
#pragma unroll
              for (int p = 0; p < 16; ++p) { const float uu = US[t * 16 + p]; bu.x += bb[p].x * uu; bu.y += bb[p].y * uu; }
              XS[t * 65 + n] = bu; } }
        __syncthreads();
        if (wave == 0) { const int n = lane; f32x2 xst = {P.st_re[(b * NG + g) * 64 + n], P.st_im[(b * NG + g) * 64 + n]}; const f32x2 ab = ABAR[g * 64 + n];
#pragma unroll 8
            for (int t = 0; t < 64; ++t) { const f32x2 bu = XS[t * 65 + n]; const f32x2 ax = cmul(ab, xst); xst = (f32x2){ax.x + bu.x, ax.y + bu.y}; XS[t * 65 + n] = xst; }
            out[O_RS + (b * NG + g) * 64 + n] = xst.x; out[O_IS + (b * NG + g) * 64 + n] = xst.y; }
        __syncthreads();
        { const int t = tid >> 3, pp = tid & 7;
#pragma unroll
          for (int e = 0; e < 2; ++e) { const int p = pp + 8 * e; float y = P.d_skip[g * 16 + p] * US[t * 16 + p];
#pragma unroll 8
              for (int n = 0; n < 64; ++n) { const f32x2 xv = XS[t * 65 + n]; y += CR[p * 65 + n] * xv.x - CI[p * 65 + n] * xv.y; }
              YSS[(size_t)(b * 64 + t) * 512 + g * 16 + p] = (bf16_t)f2bf(gelu_tanh(y)); } }
        __syncthreads();
    }
    }
    GRID_BAR();

    for (int it = blk; it < 128; it += G) {
        const int mb = it & 15, ns = it >> 4;
        LAS float* Cs = (LAS float*)lds; constexpr int ldc = 68;
        __syncthreads();
        skinny32(Cs, YSS + (size_t)(32 * mb) * SW, SW, WGLU, SW, 64, SW, [&](int ct) { return 64 * ns + 16 * ct; });
        const int tid = fresh_tid();
        if (tid < 256) { const int row = tid >> 3, ch = tid & 7, col = 64 * ns + 8 * ch, m = PT + 32 * mb + row;
            const f32x4 c0 = *(const LAS f32x4*)(Cs + row * ldc + 8 * ch) + *(const f32x4*)(P.b_glu + col), c1 = *(const LAS f32x4*)(Cs + row * ldc + 8 * ch + 4) + *(const f32x4*)(P.b_glu + col + 4);
            const u32x4 ys = *(const u32x4*)(YSS + (size_t)(m - PT) * 512 + col), zs = *(const u32x4*)(ZS + (size_t)m * 512 + col);
            u32x4 w;
            w.x = pk2(bflo(ys.x) * sigmoidf_(c0[0]) * bflo(zs.x), bfhi(ys.x) * sigmoidf_(c0[1]) * bfhi(zs.x));
            w.y = pk2(bflo(ys.y) * sigmoidf_(c0[2]) * bflo(zs.y), bfhi(ys.y) * sigmoidf_(c0[3]) * bfhi(zs.y));
            w.z = pk2(bflo(ys.z) * sigmoidf_(c1[0]) * bflo(zs.z), bfhi(ys.z) * sigmoidf_(c1[1]) * bfhi(zs.z));
            w.w = pk2(bflo(ys.w) * sigmoidf_(c1[2]) * bflo(zs.w), bfhi(ys.w) * sigmoidf_(c1[3]) * bfhi(zs.w));
            *(u32x4*)(MX + (size_t)m * 1024 + col) = w; }
        __syncthreads();
    }
    for (int repc = 0; repc < REP_CH; ++repc) {
    for (int it = blk; it < NB * NG; it += G) {
        TIDS();
        const int b = it >> 5, g = it & 31, n = lane, w = wave;
        LAS f32x2* EE = (LAS f32x2*)lds;
        const f32x2 a16 = A16[g * 64 + n];
        const float* sp = SB + ((size_t)g * NCH + b * 512 + w * 64) * 128;
        f32x2 e = {0.f, 0.f};
#pragma unroll 32
        for (int c = 0; c < 64; ++c) { const f32x2 s = {sp[c * 128 + n], sp[c * 128 + 64 + n]}; const f32x2 ax = cmul(a16, e); e = (f32x2){ax.x + s.x, ax.y + s.y}; }
        EE[w * 64 + n] = e;
        __syncthreads();
        f32x2 a64 = a16;
#pragma unroll
        for (int i = 0; i < 6; ++i) a64 = cmul(a64, a64);
        f32x2 h = {0.f, 0.f};
        for (int ww = 0; ww < w; ++ww) { const f32x2 ax = cmul(a64, h); const f32x2 ev = EE[ww * 64 + n]; h = (f32x2){ax.x + ev.x, ax.y + ev.y}; }
        bf16_t* ux = UX + ((size_t)g * UXROWS + b * 512 + w * 64) * (UXR * 16);
#pragma unroll 32
        for (int c = 0; c < 64; ++c) {
            ux[(c * UXR + 16) * 16 + n] = (bf16_t)f2bf(h.x); ux[(c * UXR + 20) * 16 + n] = (bf16_t)f2bf(h.y);
            const f32x2 s = {sp[c * 128 + n], sp[c * 128 + 64 + n]}; const f32x2 ax = cmul(a16, h); h = (f32x2){ax.x + s.x, ax.y + s.y}; }
        if (w == 7) { out[O_RP + (b * NG + g) * 64 + n] = h.x; out[O_IP + (b * NG + g) * 64 + n] = h.y; }
        __syncthreads();
    }
    }
    for (int rep = 0; rep < REP_ATT; ++rep) {
        TIDS();
        float gqm = fabsf(P.q_g[lane]), gkm = fabsf(P.k_g[lane]);
#pragma unroll
        for (int o = 1; o < 64; o <<= 1) { gqm = fmaxf(gqm, __shfl_xor(gqm, o)); gkm = fmaxf(gkm, __shfl_xor(gkm, o)); }
        const float qkmax = 64.f * gqm * gkm * C2 * 1.02f + 0.25f, thresh = 37.f + 2.f * qkmax;
        LAS unsigned* uw = (LAS unsigned*)(lds + att::LDS_UNIT);
        constexpr int NUNITS = 64 + NB * NH * (SEQ / 256);
        unsigned nxt_ui = 0u;
        if (tid == 0) nxt_ui = atomicAdd(CTL + 64 + 64 * rep, 1u);
        for (;;) {
            asm volatile("s_waitcnt lgkmcnt(0)\n\ts_barrier" ::: "memory");
            if (tid == 0) { uw[0] = nxt_ui; nxt_ui = atomicAdd(CTL + 64 + 64 * rep, 1u); }
            asm volatile("s_waitcnt lgkmcnt(0)\n\ts_barrier" ::: "memory");
            const int ui = __builtin_amdgcn_readfirstlane((int)uw[0]);
            if (ui >= NUNITS) break;
            att::UnitDesc u;
            if (ui < 64) { const int b = ui >> 3, h = ui & 7;
                u.Q = QB + (size_t)(PT + b * 64) * 512 + h * 64; u.K = KS + (size_t)b * SKV * 512 + h * 64; u.V = VS + (size_t)b * SKV * 512 + h * 64; u.LF = LFS + (size_t)b * SKV * NH + h;
                u.Zg = ZA + (size_t)(PT + b * 64) * 512 + h * 64; u.O = MX + (size_t)(PT + b * 64) * 1024 + 512 + h * 64; u.q0 = PAST; u.nq = 64; }
            else { const int r = ui - 64, qb = 31 - (r >> 6), bh = r & 63, b = bh >> 3, h = bh & 7; const size_t row0 = (size_t)b * SEQ + qb * 256;
                u.Q = QB + row0 * 512 + h * 64; u.K = KB + (size_t)b * SEQ * 512 + h * 64; u.V = VB + (size_t)b * SEQ * 512 + h * 64; u.LF = out + O_LFP + (size_t)b * SEQ * NH + h;
                u.Zg = ZA + row0 * 512 + h * 64; u.O = MX + row0 * 1024 + 512 + h * 64; u.q0 = qb * 256; u.nq = 256; }
            att::attn_unit(u, lds, qkmax, thresh);
        }
    }
    GRID_BAR();

    for (int it = blk; it < 256; it += G) {
        const int mb = it & 15, ns = it >> 4;
        LAS float* Cs = (LAS float*)lds; constexpr int ldc = 68;
        __syncthreads();
        skinny32(Cs, MX + (size_t)(PT + 32 * mb) * DM, DM, WOUT, DM, 64, DM, [&](int ct) { return 64 * ns + 16 * ct; });
        const int tid = fresh_tid();
        if (tid < 256) { const int row = tid >> 3, ch = tid & 7, col = 64 * ns + 8 * ch, sidx = 32 * mb + row; const float* gt = MOD + (size_t)(8 + (sidx >> 6)) * 3072 + 2048 + col;
            const float* xr = P.x_sample + (size_t)sidx * DM + col; float* yr = out + O_YS + (size_t)sidx * DM + col;
            *(f32x4*)yr = *(const f32x4*)xr + *(const f32x4*)gt * *(const LAS f32x4*)(Cs + row * ldc + 8 * ch);
            *(f32x4*)(yr + 4) = *(const f32x4*)(xr + 4) + *(const f32x4*)(gt + 4) * *(const LAS f32x4*)(Cs + row * ldc + 8 * ch + 4); }
        __syncthreads();
    }
    for (int rep5 = 0; rep5 < REP_P5; ++rep5) {
        pg8::Gemm g{UXR * 32, 384 * 2, 128, 128, 6, 0}; pg8::S5Order S{G, blk, (const char*)UX, (const char*)W2, (size_t)256 * 384 * 2};
        EpiY E{YS};
        pg8::gemm_phase<EpiY, pg8::S5Order>(lds, g, S, E);
    }
    GRID_BAR();

    for (int rep6 = 0; rep6 < REP_P6; ++rep6) {
        pg8::Gemm g{32, SW * 2, (size_t)4 * PT * 32, 128, SW / 64, (unsigned)(PT * 32)}; pg8::StaticOrder S; S.init(PT, SW, G, blk, YS, WGLU, 32, SW * 2);
        EpiGlu E{YS, ZS, P.b_glu, MX};
        pg8::gemm_phase<EpiGlu, pg8::StaticOrder>(lds, g, S, E);
    }
    GRID_BAR();

    for (int rep = 0; rep < REP_P7; ++rep) {
        pg8::Gemm g{DM * 2, DM * 2, 128, 128, DM / 64, 0}; pg8::StaticOrder S; S.init(PT, DM, G, blk, MX, WOUT, DM * 2, DM * 2);
        EpiOut E{P.x_prompt, P.x_sample, MOD, out + O_YP, out + O_YS};
        pg8::gemm_phase<EpiOut, pg8::StaticOrder>(lds, g, S, E);
    }
    for (int i = 0; i < EXTRA_SYNCS; ++i) GRID_BAR();
}

extern "C" void kernel_launch(void* const* d_in, const int* in_sizes, int n_in, void* d_out, int out_size, void* d_ws, size_t ws_size, hipStream_t stream) {
    static int grid = 0;
    if (grid == 0) {
        if (n_in != 27 || (size_t)out_size != O_END || ws_size < WS_END) { fprintf(stderr, "kernel_launch: unexpected shapes: n_in %d out %d ws %zu\n", n_in, out_size, ws_size); grid = -1; return; }
        int dev = 0, cus = 0, per_cu = 0;
        if (hipGetDevice(&dev) != hipSuccess || hipDeviceGetAttribute(&cus, hipDeviceAttributeMultiprocessorCount, dev) != hipSuccess) { grid = -1; return; }
        if (hipFuncSetAttribute((const void*)hymba_fwd, hipFuncAttributeMaxDynamicSharedMemorySize, LDS_BYTES) != hipSuccess) { fprintf(stderr, "kernel_launch: hipFuncSetAttribute failed\n"); grid = -1; return; }
        if (hipOccupancyMaxActiveBlocksPerMultiprocessor(&per_cu, (const void*)hymba_fwd, NTHR, LDS_BYTES) != hipSuccess || per_cu < 1) { fprintf(stderr, "kernel_launch: occupancy query gives %d\n", per_cu); (void)hipGetLastError(); grid = -1; return; }
        grid = cus;
    }
    if (grid < 0) return;
    (void)hipMemsetAsync((char*)d_ws + WS_CTL, 0, CTL_BYTES, stream);
    Params p{};
    const float** pp = (const float**)&p;
    for (int i = 0; i < 27; ++i) pp[i] = (const float*)d_in[i];
    p.out = (float*)d_out; p.ws = (unsigned char*)d_ws;
    void* args[] = {&p};
    hipError_t e = hipLaunchCooperativeKernel((const void*)hymba_fwd, dim3(grid), dim3(NTHR), args, LDS_BYTES, stream);
    if (e != hipSuccess) fprintf(stderr, "kernel_launch: cooperative launch failed: %s (grid %d)\n", hipGetErrorString(e), grid);
}
```

```cpp
#include <hip/hip_runtime.h>
#include <hip/hip_cooperative_groups.h>
#include <hip/hip_bf16.h>
#include <cstdio>
#include <cstdint>
#include <cmath>
namespace cg = cooperative_groups;

#define LAS __attribute__((address_space(3)))
typedef unsigned short bf16_t;
typedef short bf16x8 __attribute__((ext_vector_type(8)));
typedef short s16x4 __attribute__((ext_vector_type(4)));
typedef float f32x4 __attribute__((ext_vector_type(4)));
typedef float f32x2 __attribute__((ext_vector_type(2)));
typedef float f32x16 __attribute__((ext_vector_type(16)));
typedef unsigned u32x4 __attribute__((ext_vector_type(4)));
typedef unsigned u32x2 __attribute__((ext_vector_type(2)));

constexpr int DM = 1024, NB = 8, SEQ = 8192, PT = NB * SEQ  , ST = 512, MT = PT + ST  , DSEQ = 64, PAST = 2048, SKV = PAST + DSEQ  ;
constexpr int NH = 8, HD = 64, SW = 512, AW = 512, NG = 32, SP = 16, SN = 64, INW = 3080, NPROJ = 3072;
constexpr int CL = 16;
constexpr int NCH = PT / CL;
constexpr int UXR = 24;
constexpr int UXROWS = NCH + ST / CL;
__host__ __device__ __forceinline__ size_t ux_off(int m, int ch) { return ((size_t)((ch >> 4) * UXROWS + (m >> 4)) * UXR + (m & 15)) * 16 + (ch & 15); }
__host__ __device__ __forceinline__ size_t ys_off(int m, int ch) { return ((size_t)(ch >> 4) * PT + m) * 16 + (ch & 15); }
constexpr float NORM_EPS = 1e-6f;
constexpr float LOG2E = 1.4426950408889634f;
constexpr float C2 = 0.125f * LOG2E;

constexpr size_t O_YP = 0, O_YS = O_YP + (size_t)PT * DM, O_KP = O_YS + (size_t)ST * DM, O_VP = O_KP + (size_t)PT * AW, O_LFP = O_VP + (size_t)PT * AW,
                 O_RP = O_LFP + (size_t)PT * NH, O_IP = O_RP + NB * NG * SN, O_KS = O_IP + NB * NG * SN, O_VS = O_KS + (size_t)ST * AW, O_LFS = O_VS + (size_t)ST * AW,
                 O_RS = O_LFS + ST * NH, O_IS = O_RS + NB * NG * SN, O_END = O_IS + NB * NG * SN;

constexpr size_t MiB = 1u << 20;
constexpr size_t WS_CTL = 0, CTL_BYTES = 65536;
constexpr size_t WS_MOD = 1 * MiB;
constexpr size_t WS_A16 = WS_MOD + 256 * 1024;
constexpr size_t WS_ABAR = WS_A16 + 16384;
constexpr size_t WS_BBAR = WS_ABAR + 16384;
constexpr size_t WS_WIN = 2 * MiB;
constexpr size_t WS_WGLU = 8 * MiB;
constexpr size_t WS_WOUT = 9 * MiB;
constexpr size_t WS_W1 = 11 * MiB;
constexpr size_t WS_W2 = 15 * MiB;
constexpr size_t WS_XN = 24 * MiB;
constexpr size_t WS_UX = 160 * MiB;
constexpr size_t WS_ZS = 260 * MiB, WS_Q = 328 * MiB, WS_ZA = 396 * MiB;
constexpr size_t WS_KB = 464 * MiB, WS_VB = 528 * MiB;
constexpr size_t WS_KS = 592 * MiB, WS_VS = 609 * MiB;
constexpr size_t WS_LFS = 626 * MiB;
constexpr size_t WS_SB = 627 * MiB;
constexpr size_t WS_YS = 692 * MiB;
constexpr size_t WS_YSS = 757 * MiB;
constexpr size_t WS_END = 760 * MiB;

constexpr int NWAVES = 8, NTHR = 512;
constexpr int REP_P0 = 1, REP_P1 = 1, REP_P2 = 1, REP_P3 = 1, REP_CH = 1, REP_ATT = 1, REP_P5 = 1, REP_P6 = 1, REP_P7 = 1, EXTRA_SYNCS = 0;
constexpr int LDS_BYTES = 147456;
constexpr int RING_BYTES = 131072, MISC_OFF = RING_BYTES + 320;

__device__ __forceinline__ unsigned f2bf(float f) { unsigned u = __builtin_bit_cast(unsigned, f); return (u + 0x7fffu + ((u >> 16) & 1u)) >> 16; }
__device__ __forceinline__ unsigned pk2(float lo, float hi) { typedef __bf16 bf16x2_t_ __attribute__((ext_vector_type(2))); f32x2 v = {lo, hi}; return __builtin_bit_cast(unsigned, __builtin_convertvector(v, bf16x2_t_)); }
__device__ __forceinline__ float bf2f(unsigned short b) { return __builtin_bit_cast(float, (unsigned)b << 16); }
__device__ __forceinline__ float bflo(unsigned w) { return __builtin_bit_cast(float, w << 16); }
__device__ __forceinline__ float bfhi(unsigned w) { return __builtin_bit_cast(float, w & 0xffff0000u); }
__device__ __forceinline__ float sigmoidf_(float x) { return __builtin_amdgcn_rcpf(1.f + __expf(-x)); }
__device__ __forceinline__ float siluf_(float x) { return x * __builtin_amdgcn_rcpf(1.f + __expf(-x)); }
__device__ __forceinline__ float gelu_tanh(float x) { const float z = 0.7978845608028654f * (x + 0.044715f * x * x * x); return x * __builtin_amdgcn_rcpf(1.f + __expf(-2.f * z)); }

namespace pg8 {
constexpr int BM = 256, BK = 64, HALF = 128, HTB = HALF * BK * 2, STAGE_BYTES = 8 * HTB, NXCD = 8, WGM = 8;
__host__ __device__ __forceinline__ int lds_byte(int r, int c) { const int st = (r >> 4) * 2 + (c >> 5), rr = r & 15, cc = c & 31, ob = rr * 64 + cc * 2; return st * 1024 + (ob ^ (((ob >> 9) & 1) << 5)); }
__host__ __device__ __forceinline__ void stage_rc(int b, int& R, int& C) { const int st = b / 1024, sb = b % 1024, swz = sb ^ (((sb >> 9) & 1) << 5); R = (st >> 1) * 16 + swz / 64; C = (st & 1) * 32 + (swz % 64) / 2; }
__host__ __device__ __forceinline__ int perm32(int rho) { const int n = rho >> 4, i = rho & 15; return 8 * (i >> 2) + 4 * n + (i & 3); }

struct Unit { int pm, pn, g; const char* a; const char* b; };
struct Gemm { unsigned lda, ldb; size_t kstepA, kstepB; int nt; unsigned aplane; };

struct StaticOrder {
    int nM, nN, nwg, G, c; const char* A; const char* B; size_t ta, tb;
    __device__ void init(int M, int N, int G_, int c_, const void* A_, const void* B_, unsigned lda, unsigned ldb) { nM = M / BM; nN = N / BM; nwg = nM * nN; G = G_; c = c_; A = (const char*)A_; B = (const char*)B_; ta = (size_t)BM * lda; tb = (size_t)BM * ldb; }
    __device__ bool next(int i, Unit& u) const {
        const long L = (long)i * G + c; if (L >= nwg) return false;
        int wgid = (int)L; { const int q = nwg / NXCD, r = nwg % NXCD, xcd = wgid % NXCD, off = wgid / NXCD; wgid = (xcd < r ? xcd * (q + 1) : r * (q + 1) + (xcd - r) * q) + off; }
        const int nig = WGM * nN, gid = wgid / nig, fm = gid * WGM, gsz = (nM - fm) < WGM ? (nM - fm) : WGM;
        u.pm = fm + ((wgid % nig) % gsz); u.pn = (wgid % nig) / gsz; u.g = 0; u.a = A + (size_t)u.pm * ta; u.b = B + (size_t)u.pn * tb; return true;
    }
};
struct S5Order {
    int G, c; const char* A; const char* B; size_t wbytes;
    __device__ bool next(int i, Unit& u) const {
        const int L = i * G + c; if (L >= NG * (NCH / BM)) return false;
        u.g = L / (NCH / BM); u.pm = L % (NCH / BM); u.pn = 0;
        u.a = A + ((size_t)u.g * UXROWS + (size_t)u.pm * BM) * (UXR * 32); u.b = B + (size_t)u.g * wbytes; return true;
    }
};

template <class Epi, class Sched>
__device__ __forceinline__ void gemm_phase(LAS unsigned char* lds, const Gemm g, const Sched& S, const Epi& E) {
    int tid_ = threadIdx.x; asm volatile("" : "+v"(tid_));
    const int tid = tid_, wid = __builtin_amdgcn_readfirstlane(tid >> 6), lane = tid & 63, wr = wid >> 2, wc = wid & 3, fr = lane & 15, fq = lane >> 4;
    const int nt = g.nt;
    unsigned voffA[2], voffB[2];
#pragma unroll
    for (int i = 0; i < 2; ++i) { int R, C; stage_rc(tid * 16 + i * 8192, R, C); const int Rb = Epi::PERM ? ((R & ~31) + perm32(R & 31)) : R;
        voffA[i] = (unsigned)R * g.lda + (g.aplane ? (unsigned)(C >> 4) * g.aplane + (unsigned)((C & 15) * 2) : (unsigned)(C * 2)); voffB[i] = (unsigned)Rb * g.ldb + (unsigned)(C * 2); }
    const size_t kstepA = g.kstepA, kstepB = g.kstepB;
    const size_t hstepA = (size_t)HALF * g.lda, hstepB = (size_t)HALF * g.ldb;
    const unsigned ldsw = (unsigned)wid * 1024u;
    const int aoff = lds_byte(wr * 64 + fr, fq * 8), boff = lds_byte(wc * 32 + fr, fq * 8);
#define PG8_SA(b, h) (((b) * 2 + (h)) * HTB)
#define PG8_SB(b, h) ((4 + (b) * 2 + (h)) * HTB)
#define PG8_STAGE(bufoff, gbase, voff) do { _Pragma("unroll") for (int _i = 0; _i < 2; ++_i) \
        __builtin_amdgcn_global_load_lds((const unsigned*)((const char*)(gbase) + (voff)[_i]), (LAS unsigned*)(lds + (bufoff) + ldsw + _i * 8192), 16, 0, 0); } while (0)
#define PG8_LDA(dst, b, h) do { _Pragma("unroll") for (int m = 0; m < 4; ++m) _Pragma("unroll") for (int k = 0; k < 2; ++k) dst[m][k] = *(const LAS bf16x8*)(lds + PG8_SA(b, h) + aoff + m * 2048 + k * 1024); } while (0)
#define PG8_LDB(dst, b, h) do { _Pragma("unroll") for (int n = 0; n < 2; ++n) _Pragma("unroll") for (int k = 0; k < 2; ++k) dst[n][k] = *(const LAS bf16x8*)(lds + PG8_SB(b, h) + boff + n * 2048 + k * 1024); } while (0)
#define PG8_MMA(ai, bj, At, Bt) do { __builtin_amdgcn_s_setprio(1); _Pragma("unroll") for (int m = 0; m < 4; ++m) _Pragma("unroll") for (int n = 0; n < 2; ++n) _Pragma("unroll") for (int k = 0; k < 2; ++k) \
        acc[ai][bj][m][n] = __builtin_amdgcn_mfma_f32_16x16x32_bf16(Bt[n][k], At[m][k], acc[ai][bj][m][n], 0, 0, 0); __builtin_amdgcn_s_setprio(0); } while (0)
#define PG8_WAIT_V(n) asm volatile("s_waitcnt vmcnt(" #n ")" ::: "memory")
#define PG8_WAIT_L(n) asm volatile("s_waitcnt lgkmcnt(" #n ")" ::: "memory")
#define PG8_BAR __builtin_amdgcn_s_barrier()
#define PG8_SCHED __builtin_amdgcn_sched_barrier(0)
    Unit cur, nxt; int ui = 0;
    if (!S.next(0, cur)) return;
    f32x4 acc[2][2][4][2];
#pragma unroll
    for (int a = 0; a < 2; ++a)
#pragma unroll
        for (int b = 0; b < 2; ++b)
#pragma unroll
            for (int m = 0; m < 4; ++m)
#pragma unroll
                for (int n = 0; n < 2; ++n) acc[a][b][m][n] = (f32x4){0.f, 0.f, 0.f, 0.f};
    bf16x8 At[4][2], B0[2][2], B1[2][2];
    const char* cA = cur.a; const char* cB = cur.b;
    PG8_WAIT_V(0);
    PG8_STAGE(PG8_SB(0, 0), cB, voffB); PG8_STAGE(PG8_SB(0, 1), cB + hstepB, voffB); PG8_STAGE(PG8_SA(0, 0), cA, voffA); PG8_STAGE(PG8_SA(0, 1), cA + hstepA, voffA);
    if (wr == 1) PG8_BAR;
    PG8_WAIT_V(2); PG8_BAR;
    PG8_STAGE(PG8_SB(1, 0), cB + kstepB, voffB); PG8_STAGE(PG8_SA(1, 0), cA + kstepA, voffA); PG8_STAGE(PG8_SB(1, 1), cB + hstepB + kstepB, voffB);
    PG8_WAIT_V(6); PG8_BAR;
    for (;;) {
        const bool has_next = S.next(ui + 1, nxt);
        const char* nA = has_next ? nxt.a : cA; const char* nB = has_next ? nxt.b : cB;
        for (int t = 0; t < nt; t += 2) {
            const bool last = (t == nt - 2);
            const char* a1 = cA + (size_t)(t + 1) * kstepA;
            const char* a2 = last ? nA : cA + (size_t)(t + 2) * kstepA; const char* b2 = last ? nB : cB + (size_t)(t + 2) * kstepB;
            const char* a3 = a2 + kstepA; const char* b3 = b2 + kstepB;
            PG8_LDB(B0, 0, 0); PG8_LDB(B1, 0, 1); PG8_SCHED; PG8_LDA(At, 0, 0); PG8_STAGE(PG8_SA(1, 1), a1 + hstepA, voffA);
            PG8_WAIT_V(8); PG8_WAIT_L(0); PG8_BAR; PG8_MMA(0, 0, At, B0); PG8_MMA(0, 1, At, B1); PG8_BAR; PG8_SCHED;
            PG8_LDA(At, 0, 1); PG8_STAGE(PG8_SB(0, 0), b2, voffB); PG8_STAGE(PG8_SB(0, 1), b2 + hstepB, voffB); PG8_STAGE(PG8_SA(0, 0), a2, voffA);
            PG8_WAIT_V(8); PG8_WAIT_L(0); PG8_BAR; PG8_MMA(1, 0, At, B0); PG8_MMA(1, 1, At, B1); PG8_BAR; PG8_SCHED;
            PG8_LDB(B0, 1, 0); PG8_LDB(B1, 1, 1); PG8_SCHED; PG8_LDA(At, 1, 0); PG8_STAGE(PG8_SA(0, 1), a2 + hstepA, voffA);
            PG8_WAIT_V(8); PG8_WAIT_L(0); PG8_BAR; PG8_MMA(0, 0, At, B0); PG8_MMA(0, 1, At, B1); PG8_BAR; PG8_SCHED;
            PG8_LDA(At, 1, 1); PG8_STAGE(PG8_SB(1, 0), b3, voffB); PG8_STAGE(PG8_SB(1, 1), b3 + hstepB, voffB); PG8_STAGE(PG8_SA(1, 0), a3, voffA);
            PG8_WAIT_V(8); PG8_WAIT_L(0); PG8_BAR; PG8_MMA(1, 0, At, B0); PG8_MMA(1, 1, At, B1); PG8_BAR; PG8_SCHED;
        }
        if (wr == 0) PG8_BAR;
        E(acc, cur, wr, wc, fr, fq);
        if (!has_next) break;
#pragma unroll
        for (int a = 0; a < 2; ++a)
#pragma unroll
            for (int b = 0; b < 2; ++b)
#pragma unroll
                for (int m = 0; m < 4; ++m)
#pragma unroll
                    for (int n = 0; n < 2; ++n) acc[a][b][m][n] = (f32x4){0.f, 0.f, 0.f, 0.f};
        cur = nxt; cA = nA; cB = nB; ++ui;
        if (wr == 1) PG8_BAR;
    }
    PG8_WAIT_V(0);
    PG8_BAR;
#undef PG8_SA
#undef PG8_SB
#undef PG8_STAGE
#undef PG8_LDA
#undef PG8_LDB
#undef PG8_MMA
#undef PG8_WAIT_V
#undef PG8_WAIT_L
#undef PG8_BAR
#undef PG8_SCHED
}
}

struct Params {
    const float *x_prompt, *x_sample, *cache_k, *cache_v, *cache_logf, *st_re, *st_im, *c_prompt, *c_sample, *w_ada, *b_ada, *norm_g, *w_in, *b_f, *q_g, *k_g,
                *log_dt, *a_re, *a_im, *b_re, *b_im, *c_re, *c_im, *d_skip, *w_glu, *b_glu, *w_out;
    float* out; unsigned char* ws;
};

struct EpiInProj {
    static constexpr bool PERM = true;
    bf16_t *UX_, *ZS_, *Q, *ZA_, *KB_, *VB_, *KS_, *VS_; float *kp, *vp, *ksm, *vsm; const float *gq, *gk;
    __device__ __forceinline__ void operator()(const f32x4 (&acc)[2][2][4][2], const pg8::Unit& u, int wr, int wc, int fr, int fq) const {
        const int type = u.pn >> 1;
        const int cb0 = (u.pn & 1) * 256 + wc * 64 + fq * 8;
        float gg[2][8];
        if (type == 2 || type == 3) { const float* gp = (type == 2) ? gq : gk;
#pragma unroll
            for (int bj = 0; bj < 2; ++bj)
#pragma unroll
                for (int e = 0; e < 8; ++e) gg[bj][e] = gp[bj * 32 + fq * 8 + e] * (type == 2 ? C2 : 1.f); }
#pragma unroll
        for (int ai = 0; ai < 2; ++ai)
#pragma unroll
            for (int m = 0; m < 4; ++m) {
                const int row = u.pm * 256 + ai * 128 + wr * 64 + m * 16 + fr;
                float v[2][8];
#pragma unroll
                for (int bj = 0; bj < 2; ++bj)
#pragma unroll
                    for (int e = 0; e < 4; ++e) { v[bj][e] = acc[ai][bj][m][0][e]; v[bj][4 + e] = acc[ai][bj][m][1][e]; }
                if (type == 2 || type == 3) {
                    float ss = 0.f;
#pragma unroll
                    for (int bj = 0; bj < 2; ++bj)
#pragma unroll
                        for (int e = 0; e < 8; ++e) ss += v[bj][e] * v[bj][e];
                    ss += __shfl_xor(ss, 16); ss += __shfl_xor(ss, 32);
                    const float rs = rsqrtf(ss * (1.f / 64.f) + NORM_EPS);
#pragma unroll
                    for (int bj = 0; bj < 2; ++bj)
#pragma unroll
                        for (int e = 0; e < 8; ++e) v[bj][e] = v[bj][e] * rs * gg[bj][e];
                } else if (type == 1 || type == 5) {
#pragma unroll
                    for (int bj = 0; bj < 2; ++bj)
#pragma unroll
                        for (int e = 0; e < 8; ++e) v[bj][e] = siluf_(v[bj][e]);
                }
                bf16_t* bdst; float* fdst = nullptr;
                if (type == 0) bdst = UX_;
                else if (type == 1) bdst = ZS_ + (size_t)row * 512;
                else if (type == 2) bdst = Q + (size_t)row * 512;
                else if (type == 5) bdst = ZA_ + (size_t)row * 512;
                else {
                    if (row < PT) { bdst = (type == 3 ? KB_ : VB_) + (size_t)row * 512; fdst = (type == 3 ? kp : vp) + (size_t)row * 512; }
                    else { const int s = row - PT, b = s >> 6, t = s & 63; bdst = (type == 3 ? KS_ : VS_) + (size_t)(b * SKV + PAST + t) * 512; fdst = (type == 3 ? ksm : vsm) + (size_t)s * 512; }
                }
#pragma unroll
                for (int bj = 0; bj < 2; ++bj) {
                    u32x4 w; w.x = pk2(v[bj][0], v[bj][1]); w.y = pk2(v[bj][2], v[bj][3]); w.z = pk2(v[bj][4], v[bj][5]); w.w = pk2(v[bj][6], v[bj][7]);
                    *(u32x4*)(bdst + (type == 0 ? ux_off(row, cb0 + bj * 32) : (size_t)(cb0 + bj * 32))) = w;
                    if (fdst) { *(f32x4*)(fdst + cb0 + bj * 32) = (f32x4){v[bj][0], v[bj][1], v[bj][2], v[bj][3]}; *(f32x4*)(fdst + cb0 + bj * 32 + 4) = (f32x4){v[bj][4], v[bj][5], v[bj][6], v[bj][7]}; }
                }
            }
    }
};
struct EpiS {
    static constexpr bool PERM = true;
    float* SB_;
    __device__ __forceinline__ void operator()(const f32x4 (&acc)[2][2][4][2], const pg8::Unit& u, int wr, int wc, int fr, int fq) const {
#pragma unroll
        for (int ai = 0; ai < 2; ++ai)
#pragma unroll
            for (int m = 0; m < 4; ++m) {
                const int row = u.pm * 256 + ai * 128 + wr * 64 + m * 16 + fr;
                float* d = SB_ + ((size_t)u.g * NCH + row) * 128 + wc * 32 + fq * 8;
                *(f32x4*)d = acc[ai][0][m][0]; *(f32x4*)(d + 4) = acc[ai][0][m][1];
            }
    }
};
struct EpiY {
    static constexpr bool PERM = true;
    bf16_t* YS_;
    __device__ __forceinline__ void operator()(const f32x4 (&acc)[2][2][4][2], const pg8::Unit& u, int wr, int wc, int fr, int fq) const {
#pragma unroll
        for (int ai = 0; ai < 2; ++ai)
#pragma unroll
            for (int m = 0; m < 4; ++m) {
                const int row = u.pm * 256 + ai * 128 + wr * 64 + m * 16 + fr;
#pragma unroll
                for (int bj = 0; bj < 2; ++bj) {
                    const int t = 8 * bj + 2 * wc + (fq >> 1), p0 = 8 * (fq & 1);
                    const f32x4 a = acc[ai][bj][m][0], b = acc[ai][bj][m][1];
                    u32x4 w; w.x = pk2(gelu_tanh(a[0]), gelu_tanh(a[1])); w.y = pk2(gelu_tanh(a[2]), gelu_tanh(a[3])); w.z = pk2(gelu_tanh(b[0]), gelu_tanh(b[1])); w.w = pk2(gelu_tanh(b[2]), gelu_tanh(b[3]));
                    *(u32x4*)(YS_ + ys_off(row * CL + t, u.g * 16 + p0)) = w;
                }
            }
    }
};
struct EpiGlu {
    static constexpr bool PERM = true;
    const bf16_t *YS_, *ZS_; const float* bglu; bf16_t* MX_;
    __device__ __forceinline__ void operator()(const f32x4 (&acc)[2][2][4][2], const pg8::Unit& u, int wr, int wc, int fr, int fq) const {
#pragma unroll
        for (int bj = 0; bj < 2; ++bj) {
            const int col = u.pn * 256 + bj * 128 + wc * 32 + fq * 8;
            const f32x4 b0 = *(const f32x4*)(bglu + col), b1 = *(const f32x4*)(bglu + col + 4);
#pragma unroll
            for (int ai = 0; ai < 2; ++ai) {
                u32x4 ysv[4], zsv[4];
#pragma unroll
                for (int m = 0; m < 4; ++m) { const int row = u.pm * 256 + ai * 128 + wr * 64 + m * 16 + fr;
                    ysv[m] = *(const u32x4*)(YS_ + ys_off(row, col)); zsv[m] = *(const u32x4*)(ZS_ + (size_t)row * 512 + col); }
                asm volatile("" ::: "memory");
#pragma unroll
                for (int m = 0; m < 4; ++m) {
                    const int row = u.pm * 256 + ai * 128 + wr * 64 + m * 16 + fr;
                    const u32x4 ys = ysv[m], zs = zsv[m];
                    const f32x4 a = acc[ai][bj][m][0] + b0, b = acc[ai][bj][m][1] + b1;
                    u32x4 w;
                    w.x = pk2(bflo(ys.x) * sigmoidf_(a[0]) * bflo(zs.x), bfhi(ys.x) * sigmoidf_(a[1]) * bfhi(zs.x));
                    w.y = pk2(bflo(ys.y) * sigmoidf_(a[2]) * bflo(zs.y), bfhi(ys.y) * sigmoidf_(a[3]) * bfhi(zs.y));
                    w.z = pk2(bflo(ys.z) * sigmoidf_(b[0]) * bflo(zs.z), bfhi(ys.z) * sigmoidf_(b[1]) * bfhi(zs.z));
                    w.w = pk2(bflo(ys.w) * sigmoidf_(b[2]) * bflo(zs.w), bfhi(ys.w) * sigmoidf_(b[3]) * bfhi(zs.w));
                    *(u32x4*)(MX_ + (size_t)row * 1024 + col) = w;
                }
                asm volatile("" ::: "memory");
            }
            asm volatile("" ::: "memory");
        }
    }
};
struct EpiOut {
    static constexpr bool PERM = false;
    const float *xp, *xs, *mod; float *yp, *ys;
    __device__ __forceinline__ void operator()(const f32x4 (&acc)[2][2][4][2], const pg8::Unit& u, int wr, int wc, int fr, int fq) const {
        const int row0 = u.pm * 256 + wr * 64 + fr, col0 = u.pn * 256 + wc * 32 + fq * 4;
        const float* gt = mod + (size_t)(row0 >> 13) * 3072 + 2048 + col0;
        f32x4 gv[2][2];
#pragma unroll
        for (int bj = 0; bj < 2; ++bj)
#pragma unroll
            for (int n = 0; n < 2; ++n) gv[bj][n] = *(const f32x4*)(gt + bj * 128 + 16 * n);
#pragma unroll
        for (int ai = 0; ai < 2; ++ai)
#pragma unroll
            for (int mp = 0; mp < 2; ++mp) {
                f32x4 xv[2][2][2];
#pragma unroll
                for (int mm = 0; mm < 2; ++mm) { const float* xr = xp + (size_t)(row0 + ai * 128 + (2 * mp + mm) * 16) * DM + col0;
#pragma unroll
                    for (int bj = 0; bj < 2; ++bj)
#pragma unroll
                        for (int n = 0; n < 2; ++n) xv[mm][bj][n] = *(const f32x4*)(xr + bj * 128 + 16 * n); }
                asm volatile("" ::: "memory");
#pragma unroll
                for (int mm = 0; mm < 2; ++mm) { float* yr = yp + (size_t)(row0 + ai * 128 + (2 * mp + mm) * 16) * DM + col0;
#pragma unroll
                    for (int bj = 0; bj < 2; ++bj)
#pragma unroll
                        for (int n = 0; n < 2; ++n) { const f32x4 yv = xv[mm][bj][n] + gv[bj][n] * acc[ai][bj][2 * mp + mm][n]; const float* yp_ = yr + bj * 128 + 16 * n;
                            asm volatile("global_store_dwordx4 %0, %1, off sc1" :: "v"(yp_), "v"(yv) : "memory"); } }
                asm volatile("" ::: "memory");
            }
    }
};

namespace att {
constexpr int LDS_K = 0, LDS_V = 8192, LDS_WS = 32768, LDS_LX = 36864, LDS_OST = 37888, LDS_UNIT = 70656;
__device__ __forceinline__ int crow(int r, int hi) { return (r & 3) + 8 * (r >> 2) + 4 * hi; }
__device__ __forceinline__ unsigned cvtpk(float lo, float hi) { typedef __bf16 bf16x2_t __attribute__((ext_vector_type(2))); f32x2 v = {lo, hi}; bf16x2_t b = __builtin_convertvector(v, bf16x2_t); return __builtin_bit_cast(unsigned, b); }
struct UnitDesc { const bf16_t* Q; const bf16_t* K; const bf16_t* V; const float* LF; const bf16_t* Zg; bf16_t* O; int q0, nq; };

__device__ __forceinline__ void pv(f32x16* o, int vb, bf16x8 pa0, bf16x8 pa1, bf16x8 pa2, bf16x8 pa3) {
#pragma unroll
    for (int d0 = 0; d0 < 2; ++d0) { s16x4 lo[4], hi[4];
#pragma unroll
        for (int ks = 0; ks < 4; ++ks) {
            asm volatile("ds_read_b64_tr_b16 %0,%1 offset:%c2" : "=&v"(lo[ks]) : "v"(vb), "i"(d0 * 4096 + ks * 1024) : "memory");
            asm volatile("ds_read_b64_tr_b16 %0,%1 offset:%c2" : "=&v"(hi[ks]) : "v"(vb), "i"(d0 * 4096 + ks * 1024 + 512) : "memory"); }
        asm volatile("s_waitcnt lgkmcnt(0)" ::: "memory"); __builtin_amdgcn_sched_barrier(0);
#define PK(k) (bf16x8){lo[k][0], lo[k][1], lo[k][2], lo[k][3], hi[k][0], hi[k][1], hi[k][2], hi[k][3]}
        o[d0] = __builtin_amdgcn_mfma_f32_32x32x16_bf16(pa0, PK(0), o[d0], 0, 0, 0);
        o[d0] = __builtin_amdgcn_mfma_f32_32x32x16_bf16(pa1, PK(1), o[d0], 0, 0, 0);
        o[d0] = __builtin_amdgcn_mfma_f32_32x32x16_bf16(pa2, PK(2), o[d0], 0, 0, 0);
        o[d0] = __builtin_amdgcn_mfma_f32_32x32x16_bf16(pa3, PK(3), o[d0], 0, 0, 0);
#undef PK
    }
}
__device__ __forceinline__ float dpp_shl(float v, int) { return v; }
#define DPP_SHL(v, n) __builtin_bit_cast(float, __builtin_amdgcn_update_dpp(0, __builtin_bit_cast(int, (v)), 0x100 | (n), 0xF, 0xF, true))
__device__ __forceinline__ float suffix_incl(float v, int lane) {
    v += DPP_SHL(v, 1); v += DPP_SHL(v, 2); v += DPP_SHL(v, 4); v += DPP_SHL(v, 8);
    const float t1 = __builtin_bit_cast(float, __builtin_amdgcn_readlane(__builtin_bit_cast(int, v), 16)), t2 = __builtin_bit_cast(float, __builtin_amdgcn_readlane(__builtin_bit_cast(int, v), 32)),
                t3 = __builtin_bit_cast(float, __builtin_amdgcn_readlane(__builtin_bit_cast(int, v), 48));
    const int row = lane >> 4;
    const float add = (row == 0) ? (t1 + t2) + t3 : (row == 1) ? t2 + t3 : (row == 2) ? t3 : 0.f;
    return v + add;
}
__device__ __forceinline__ float lane0(float v) { return __builtin_bit_cast(float, __builtin_amdgcn_readfirstlane(__builtin_bit_cast(int, v))); }
template <bool BAND>
__device__ __forceinline__ void tile_body(f32x16* o, float& l_reg, const bf16x8* qr, const LAS unsigned char* kbs, const LAS float* wb, int vb, float ci, int hi, int keybase, int qabs) {
    f32x16 p0, p1;
#pragma unroll
    for (int g4 = 0; g4 < 4; ++g4) {
        const f32x4 ba = *(const LAS f32x4*)(wb + 8 * g4 + 4 * hi) + ci, bb = *(const LAS f32x4*)(wb + 32 + 8 * g4 + 4 * hi) + ci;
#pragma unroll
        for (int e = 0; e < 4; ++e) { p0[4 * g4 + e] = ba[e]; p1[4 * g4 + e] = bb[e]; }
    }
#pragma unroll
    for (int d0 = 0; d0 < 4; ++d0) {
        const bf16x8 b0 = *(const LAS bf16x8*)(kbs + d0 * 2048), b1 = *(const LAS bf16x8*)(kbs + d0 * 2048 + 512);
        p0 = __builtin_amdgcn_mfma_f32_32x32x16_bf16(b0, qr[d0], p0, 0, 0, 0); p1 = __builtin_amdgcn_mfma_f32_32x32x16_bf16(b1, qr[d0], p1, 0, 0, 0); }
    if (BAND) {
#pragma unroll
        for (int r = 0; r < 16; ++r) { const int key = keybase + 8 * (r >> 2) + (r & 3); if (key > qabs) p0[r] = -INFINITY; if (key + 32 > qabs) p1[r] = -INFINITY; }
    }
    f32x2 s2 = {0.f, 0.f};
#pragma unroll
    for (int r = 0; r < 16; r += 2) {
        p0[r] = __builtin_amdgcn_exp2f(p0[r]); p0[r + 1] = __builtin_amdgcn_exp2f(p0[r + 1]); p1[r] = __builtin_amdgcn_exp2f(p1[r]); p1[r + 1] = __builtin_amdgcn_exp2f(p1[r + 1]);
        s2 += (f32x2){p0[r], p0[r + 1]}; s2 += (f32x2){p1[r], p1[r + 1]}; }
    l_reg += s2.x + s2.y;
    u32x4 pw0, pw1, pw2, pw3;
    pw0 = (u32x4){cvtpk(p0[0], p0[1]), cvtpk(p0[2], p0[3]), cvtpk(p0[4], p0[5]), cvtpk(p0[6], p0[7])};
    pw1 = (u32x4){cvtpk(p0[8], p0[9]), cvtpk(p0[10], p0[11]), cvtpk(p0[12], p0[13]), cvtpk(p0[14], p0[15])};
    pw2 = (u32x4){cvtpk(p1[0], p1[1]), cvtpk(p1[2], p1[3]), cvtpk(p1[4], p1[5]), cvtpk(p1[6], p1[7])};
    pw3 = (u32x4){cvtpk(p1[8], p1[9]), cvtpk(p1[10], p1[11]), cvtpk(p1[12], p1[13]), cvtpk(p1[14], p1[15])};
    pv(o, vb, __builtin_bit_cast(bf16x8, pw0), __builtin_bit_cast(bf16x8, pw1), __builtin_bit_cast(bf16x8, pw2), __builtin_bit_cast(bf16x8, pw3));
}
#ifndef ATT_SKIP
#define ATT_SKIP 1
#endif
__device__ __forceinline__ void attn_unit(const UnitDesc& u, LAS unsigned char* shm, float qkmax, float thresh) {
    int tid_ = threadIdx.x; asm volatile("" : "+v"(tid_));
    const int tid = tid_, lane = tid & 63, r32 = lane & 31, hi = lane >> 5; const int wid = __builtin_amdgcn_readfirstlane(tid >> 6);
    const int NT = (u.q0 + u.nq) >> 6, nband = u.nq >> 6;
    const bool active = wid * 32 < u.nq;
    LAS float* wsf = (LAS float*)(shm + LDS_WS) + wid * 128;
    const bf16_t* ksrc = u.K + (size_t)lane * 512 + wid * 8;
    const bf16_t* vsrc = u.V + (size_t)(16 * (wid & 3) + (lane >> 2)) * 512 + (wid >> 2) * 32 + (lane & 3) * 8;
    const float* lsrc = u.LF + (size_t)lane * 8;
    LAS unsigned char* kdst = shm + LDS_K + wid * 1024 + lane * 16;
    LAS unsigned char* vdst = shm + LDS_V + wid * 1024 + lane * 16;
    const int vb0 = (int)(unsigned)(uintptr_t)(shm + LDS_V) + ((lane >> 4) & 1) * 32 + (lane & 3) * 8 + (4 * hi + ((lane & 15) >> 2)) * 64;
    const LAS unsigned char* kb = shm + LDS_K + hi * 1024 + r32 * 16;
#define ATT_GLD16(dst, ptr) asm volatile("global_load_dwordx4 %0, %1, off" : "=&v"(dst) : "v"(ptr) : "memory")
#define ATT_GLD4(dst, ptr)  asm volatile("global_load_dword %0, %1, off" : "=&v"(dst) : "v"(ptr) : "memory")
    u32x4 kreg = *(const u32x4*)(ksrc + (size_t)(NT - 1) * 64 * 512), vreg = *(const u32x4*)(vsrc + (size_t)(NT - 1) * 64 * 512);
    float lfb[4];
#pragma unroll
    for (int jb = 0; jb < 4; ++jb) { const int tile = NT - 1 - jb; lfb[jb] = lsrc[(size_t)(tile > 0 ? tile : 0) * 64 * 8]; }
    u32x4 kA, vA, kB, vB, kC, vC;
    { const int t2 = NT >= 2 ? NT - 2 : 0, t3 = NT >= 3 ? NT - 3 : 0, t4 = NT >= 4 ? NT - 4 : 0;
      ATT_GLD16(kA, ksrc + (size_t)t2 * 64 * 512); ATT_GLD16(vA, vsrc + (size_t)t2 * 64 * 512);
      ATT_GLD16(kB, ksrc + (size_t)t3 * 64 * 512); ATT_GLD16(vB, vsrc + (size_t)t3 * 64 * 512);
      ATT_GLD16(kC, ksrc + (size_t)t4 * 64 * 512); ATT_GLD16(vC, vsrc + (size_t)t4 * 64 * 512); }
    bf16x8 qr[4];
#pragma unroll
    for (int d0 = 0; d0 < 4; ++d0) qr[d0] = (bf16x8){0, 0, 0, 0, 0, 0, 0, 0};
    if (active) { const bf16_t* Qw = u.Q + (size_t)(wid * 32 + r32) * 512;
#pragma unroll
        for (int d0 = 0; d0 < 4; ++d0) qr[d0] = *(const bf16x8*)(Qw + d0 * 16 + hi * 8); }
    float carry = 0.f, Rown = 0.f, Rq0 = 0.f, inc4[4];
#pragma unroll
    for (int i = 0; i < 4; ++i) inc4[i] = suffix_incl(lfb[i], lane);
#pragma unroll
    for (int i = 0; i < 4; ++i) { if (i < nband) { const int jb = nband - 1 - i; const float R = carry + inc4[i] - lfb[i];
        const float ro = __shfl(R, 32 * (wid & 1) + r32); if (jb == (wid >> 1)) Rown = ro;
        if (jb == 0) Rq0 = __shfl(R, 0);
        carry += lane0(inc4[i]); } }
    const float ci = -Rown * LOG2E - qkmax;
    const float kbq0 = Rq0 * LOG2E;
    const int qabs = u.q0 + wid * 32 + r32;
    float l_reg = 0.f; f32x16 o[2]; o[0] = f32x16{}; o[1] = f32x16{};
    float lA = lfb[1], lB = lfb[2], lC = lfb[3];
    { const float lf = lfb[0]; const float inc = inc4[0]; wsf[lane] = (inc - lf) * LOG2E; carry = lane0(inc);
      *(LAS u32x4*)kdst = kreg; *(LAS u32x4*)vdst = vreg;
      asm volatile("" : "+v"(qr[0]), "+v"(qr[1]), "+v"(qr[2]), "+v"(qr[3]));
      asm volatile("s_waitcnt vmcnt(0)" : "+v"(kA), "+v"(vA), "+v"(kB), "+v"(vB), "+v"(kC), "+v"(vC) :: "memory"); }
    int slot = 0, tile = NT - 1; bool stop = false;
#define ATT_ITER(KR, VR, LR) do { \
        const float carry_t = carry;                         \
        asm volatile("s_waitcnt lgkmcnt(0)\n\ts_barrier" ::: "memory"); \
        asm volatile("s_waitcnt vmcnt(6)" : "+v"(KR), "+v"(VR), "+v"(LR) :: "memory"); \
        { const float lf = LR; const float inc = suffix_incl(lf, lane); \
          wsf[(slot ^ 1) * 64 + lane] = (carry + inc - lf) * LOG2E; carry += lane0(inc); \
          *(LAS u32x4*)(kdst + (slot ^ 1) * 16384) = KR; *(LAS u32x4*)(vdst + (slot ^ 1) * 16384) = VR; \
          asm volatile("s_waitcnt lgkmcnt(0)" ::: "memory");                     \
          const int tn = tile >= 4 ? tile - 4 : 0; \
          ATT_GLD4(LR, lsrc + (size_t)tn * 64 * 8); ATT_GLD16(KR, ksrc + (size_t)tn * 64 * 512); ATT_GLD16(VR, vsrc + (size_t)tn * 64 * 512); } \
        if (active) { \
            if (tile * 64 > u.q0 + wid * 32 + 31) {   } \
            else if (tile >= NT - nband) tile_body<true>(o, l_reg, qr, kb + slot * 16384, wsf + slot * 64, vb0 + slot * 16384, ci, hi, tile * 64 + 4 * hi, qabs); \
            else tile_body<false>(o, l_reg, qr, kb + slot * 16384, wsf + slot * 64, vb0 + slot * 16384, ci, hi, tile * 64 + 4 * hi, qabs); \
        } \
        slot ^= 1; \
        stop = (tile == 0) || (ATT_SKIP && (carry_t * LOG2E - kbq0 < -thresh));     \
        --tile; } while (0)
    for (;;) {
        ATT_ITER(kA, vA, lA); if (stop) break;
        ATT_ITER(kB, vB, lB); if (stop) break;
        ATT_ITER(kC, vC, lC); if (stop) break;
    }
#undef ATT_ITER
    asm volatile("s_waitcnt vmcnt(0)" : "+v"(kA), "+v"(vA), "+v"(kB), "+v"(vB), "+v"(kC), "+v"(vC), "+v"(lA), "+v"(lB), "+v"(lC) :: "memory");
    if (active) {
        u32x4 zv4[4];
#pragma unroll
        for (int i = 0; i < 4; ++i) zv4[i] = *(const u32x4*)(u.Zg + (size_t)(wid * 32 + i * 8 + (lane >> 3)) * 512 + (lane & 7) * 8);
        { auto rr = __builtin_amdgcn_permlane32_swap(__float_as_uint(l_reg), __float_as_uint(l_reg), false, false); l_reg = __uint_as_float(rr[0]) + __uint_as_float(rr[1]); }
        LAS float* lx = (LAS float*)(shm + LDS_LX) + wid * 32;
        if (hi == 0) lx[r32] = l_reg;
        asm volatile("s_waitcnt lgkmcnt(0)" ::: "memory");
        float rli[16];
#pragma unroll
        for (int r = 0; r < 16; ++r) rli[r] = 1.f / lx[crow(r, hi)];
        LAS bf16_t* stg = (LAS bf16_t*)(shm + LDS_OST) + wid * 2048;
#pragma unroll
        for (int r = 0; r < 16; ++r) { const int orow = crow(r, hi);
#pragma unroll
            for (int d0 = 0; d0 < 2; ++d0) stg[orow * 64 + d0 * 32 + r32] = (bf16_t)f2bf(o[d0][r] * rli[r]); }
        asm volatile("s_waitcnt lgkmcnt(0)" ::: "memory");
#pragma unroll
        for (int i = 0; i < 4; ++i) { const int row = i * 8 + (lane >> 3), ch = lane & 7;
            const u32x4 ov = *(const LAS u32x4*)(stg + row * 64 + ch * 8);
            const u32x4 zv = zv4[i];
            u32x4 w; w.x = pk2(bflo(ov.x) * bflo(zv.x), bfhi(ov.x) * bfhi(zv.x)); w.y = pk2(bflo(ov.y) * bflo(zv.y), bfhi(ov.y) * bfhi(zv.y));
            w.z = pk2(bflo(ov.z) * bflo(zv.z), bfhi(ov.z) * bfhi(zv.z)); w.w = pk2(bflo(ov.w) * bflo(zv.w), bfhi(ov.w) * bfhi(zv.w));
            *(u32x4*)(u.O + (size_t)(wid * 32 + row) * 1024 + ch * 8) = w; }
    }
}
}


#define XB_TMO      128
#define XB_XCNT(j)  (256  + 64 * (j))
#define XB_XSUB(j)  (1280 + 64 * (j))
#define XB_XGEN(j)  (2304 + 64 * (j))
#define XB_TOP      3328
#define XB_TOPGEN   3392
#define XCD_BAR_WORDS 3456
#define XB_SPIN_CAP (1u << 18)
__device__ __forceinline__ unsigned xb_ld(unsigned* p)              { return __hip_atomic_load(p, __ATOMIC_RELAXED, __HIP_MEMORY_SCOPE_AGENT); }
__device__ __forceinline__ unsigned xb_add(unsigned* p, unsigned v) { return __hip_atomic_fetch_add(p, v, __ATOMIC_RELAXED, __HIP_MEMORY_SCOPE_AGENT); }
__device__ __forceinline__ unsigned xb_xcc_id() { return (unsigned)__builtin_amdgcn_s_getreg((3 << 11) | 20) & 0xFu; }
#define XB_SPIN(cond, bar) do { unsigned _sp = 0; while (cond) { __builtin_amdgcn_s_sleep(1); \
    if ((++_sp & 255u) == 0u) { if (xb_ld(&(bar)[XB_TMO])) break; if (_sp > XB_SPIN_CAP) { atomicAdd(&(bar)[XB_TMO], 1u); break; } } } } while (0)
struct XcdBarrier { unsigned* bar; unsigned x; volatile LAS unsigned* st; };
__device__ __forceinline__ XcdBarrier xcd_barrier_post(unsigned* bar, volatile LAS unsigned* st) {
    XcdBarrier b; b.bar = bar; b.x = xb_xcc_id(); b.st = st;
    if (threadIdx.x == 0) (void)xb_add(&bar[XB_XCNT(b.x)], 1u);
    return b;
}
__device__ __forceinline__ void xcd_barrier_complete(unsigned* bar, unsigned x, unsigned& nloc, unsigned& nx) {
    const unsigned G = gridDim.x * gridDim.y * gridDim.z;
    unsigned sum, cnt, mine, sp = 0u;
    for (;;) {
        sum = 0u; cnt = 0u; mine = 0u;
#pragma unroll
        for (unsigned j = 0; j < 16; ++j) { const unsigned c = xb_ld(&bar[XB_XCNT(j)]); sum += c; cnt += (c > 0u) ? 1u : 0u; mine = (j == x) ? c : mine; }
        if (sum == G) break;
        __builtin_amdgcn_s_sleep(1);
        if ((++sp & 255u) == 0u) { if (xb_ld(&bar[XB_TMO])) break; if (sp > XB_SPIN_CAP) { atomicAdd(&bar[XB_TMO], 1u); break; } }
    }
    nloc = mine > 0u ? mine : 1u; nx = cnt > 0u ? cnt : 1u;
}
__device__ __forceinline__ void xcd_barrier(const XcdBarrier& b) {
    asm volatile("s_waitcnt vmcnt(0)" ::: "memory");
    __syncthreads();
    if (threadIdx.x == 0) {
        unsigned* bar = b.bar;
        __builtin_amdgcn_s_waitcnt(0);
        unsigned nloc = b.st[0], nx = b.st[1];
        if (nloc == 0u) { xcd_barrier_complete(bar, b.x, nloc, nx); b.st[0] = nloc; b.st[1] = nx; }
        const unsigned old = xb_add(&bar[XB_XSUB(b.x)], 1u);
        const unsigned gen = old / nloc;
        if (old + 1u == (gen + 1u) * nloc) {
            __builtin_amdgcn_fence(__ATOMIC_RELEASE, "agent");
            asm volatile("s_waitcnt vmcnt(0)" ::: "memory");
            const unsigned og = xb_add(&bar[XB_TOP], 1u);
            const unsigned tg = og / nx;
            if (og + 1u == (tg + 1u) * nx) xb_add(&bar[XB_TOPGEN], 1u);
            else XB_SPIN(xb_ld(&bar[XB_TOPGEN]) == tg, bar);
            __builtin_amdgcn_fence(__ATOMIC_ACQUIRE, "agent");
            xb_add(&bar[XB_XGEN(b.x)], 1u);
            asm volatile("s_waitcnt vmcnt(0)" ::: "memory");
        } else {
            XB_SPIN(xb_ld(&bar[XB_XGEN(b.x)]) == gen, bar);
            __builtin_amdgcn_fence(__ATOMIC_ACQUIRE, "agent");
            asm volatile("s_waitcnt vmcnt(0)" ::: "memory");
        }
    }
    __syncthreads();
}

__device__ __forceinline__ float wave_sum(float v) {
#pragma unroll
    for (int o = 1; o < 64; o <<= 1) v += __shfl_xor(v, o);
    return v;
}
template <bool HPERM>
__device__ __forceinline__ void p0_transpose_item(const float* W, int K, int N, int ldw, bf16_t* WT, LAS float* scr, int item, int lane) {
    const int nblk = N / 32, kb = item / nblk, nb = item % nblk, k0 = 64 * kb, n0 = 32 * nb;
#pragma unroll
    for (int i = 0; i < 32; ++i) { const int kk = 2 * i + (lane >> 5); scr[kk * 33 + (lane & 31)] = W[(size_t)(k0 + kk) * ldw + n0 + (lane & 31)]; }
    asm volatile("s_waitcnt lgkmcnt(0)" ::: "memory");
    int r0 = n0;
    if (HPERM) { const int o = n0 & 255, wc = o >> 6, bj = (o >> 5) & 1; r0 = (n0 & ~255) + 128 * bj + 32 * wc; }
    const int c = lane & 7;
#pragma unroll
    for (int j = 0; j < 4; ++j) { const int n = (lane >> 3) + 8 * j; const LAS float* s = scr + (8 * c) * 33 + n;
        u32x4 o; o.x = pk2(s[0 * 33], s[1 * 33]); o.y = pk2(s[2 * 33], s[3 * 33]); o.z = pk2(s[4 * 33], s[5 * 33]); o.w = pk2(s[6 * 33], s[7 * 33]);
        *(u32x4*)(WT + (size_t)(r0 + n) * K + k0 + 8 * c) = o; }
    asm volatile("s_waitcnt lgkmcnt(0)" ::: "memory");
}
__device__ __forceinline__ int fresh_tid() { int t = threadIdx.x; asm volatile("" : "+v"(t)); return t; }
#define TIDS() const int tid = fresh_tid(), lane = tid & 63, wave = __builtin_amdgcn_readfirstlane(tid >> 6); (void)lane; (void)wave
__device__ __forceinline__ f32x2 cmul(f32x2 a, f32x2 b) { return (f32x2){a.x * b.x - a.y * b.y, a.x * b.y + a.y * b.x}; }


template <class BRow>
__device__ __forceinline__ void skinny32(LAS float* Cs, const bf16_t* A, int lda, const bf16_t* Bt, int ldb, int NC, int K, const BRow& brow) {
    const int tid = fresh_tid(), lane = tid & 63, wave = __builtin_amdgcn_readfirstlane(tid >> 6), fr = lane & 15, fq = lane >> 4;
    const int nct = NC >> 4, ldc = NC + 4;
    for (int ct = wave; ct < nct; ct += NWAVES) {
        f32x4 acc0 = {0.f, 0.f, 0.f, 0.f}, acc1 = acc0;
        const bf16_t* ap = A + (size_t)fr * lda + fq * 8; const bf16_t* bp = Bt + (size_t)(brow(ct) + fr) * ldb + fq * 8;
        bf16x8 a0[8], a1[8], b[8];
#pragma unroll
        for (int i = 0; i < 8; ++i) { a0[i] = *(const bf16x8*)(ap + 32 * i); a1[i] = *(const bf16x8*)(ap + (size_t)16 * lda + 32 * i); b[i] = *(const bf16x8*)(bp + 32 * i); }
#pragma unroll 1
        for (int k0 = 0; k0 < K; k0 += 256) {
            bf16x8 n0[8], n1[8], nb[8];
            const int kn = (k0 + 256 < K) ? k0 + 256 : k0;
#pragma unroll
            for (int i = 0; i < 8; ++i) { n0[i] = *(const bf16x8*)(ap + kn + 32 * i); n1[i] = *(const bf16x8*)(ap + (size_t)16 * lda + kn + 32 * i); nb[i] = *(const bf16x8*)(bp + kn + 32 * i); }
#pragma unroll
            for (int i = 0; i < 8; ++i) { acc0 = __builtin_amdgcn_mfma_f32_16x16x32_bf16(b[i], a0[i], acc0, 0, 0, 0); acc1 = __builtin_amdgcn_mfma_f32_16x16x32_bf16(b[i], a1[i], acc1, 0, 0, 0); }
#pragma unroll
            for (int i = 0; i < 8; ++i) { a0[i] = n0[i]; a1[i] = n1[i]; b[i] = nb[i]; }
        }
        *(LAS f32x4*)(Cs + fr * ldc + ct * 16 + 4 * fq) = acc0; *(LAS f32x4*)(Cs + (16 + fr) * ldc + ct * 16 + 4 * fq) = acc1;
    }
    __syncthreads();
}

#define WSP(T, off) ((T*)(P.ws + (off)))
#define MOD WSP(float, WS_MOD)
#define A16 WSP(f32x2, WS_A16)
#define ABAR WSP(f32x2, WS_ABAR)
#define BBAR WSP(f32x2, WS_BBAR)
#define WIN WSP(bf16_t, WS_WIN)
#define WGLU WSP(bf16_t, WS_WGLU)
#define WOUT WSP(bf16_t, WS_WOUT)
#define W1 WSP(bf16_t, WS_W1)
#define W2 WSP(bf16_t, WS_W2)
#define XN WSP(bf16_t, WS_XN)
#define MX WSP(bf16_t, WS_XN)
#define UX WSP(bf16_t, WS_UX)
#define ZS WSP(bf16_t, WS_ZS)
#define QB WSP(bf16_t, WS_Q)
#define ZA WSP(bf16_t, WS_ZA)
#define KB WSP(bf16_t, WS_KB)
#define VB WSP(bf16_t, WS_VB)
#define KS WSP(bf16_t, WS_KS)
#define VS WSP(bf16_t, WS_VS)
#define LFS WSP(float, WS_LFS)
#define SB WSP(float, WS_SB)
#define YS WSP(bf16_t, WS_YS)
#define YSS WSP(bf16_t, WS_YSS)
#define CTL WSP(unsigned, WS_CTL)
__global__ void __launch_bounds__(NTHR, 2) hymba_fwd(Params P) {
    extern __shared__ __attribute__((aligned(16))) unsigned char lds_raw[];
    cg::grid_group grid = cg::this_grid();
    LAS unsigned char* lds = (LAS unsigned char*)lds_raw;
    const int G = gridDim.x, blk = blockIdx.x;
    float* out = P.out;
    if (threadIdx.x < 32) ((LAS unsigned*)(lds + MISC_OFF))[threadIdx.x] = 0u;
    __syncthreads();
    const XcdBarrier xbar = xcd_barrier_post(CTL + 4096, (volatile LAS unsigned*)(lds + MISC_OFF) + 8);
#define GRID_BAR() xcd_barrier(xbar)

    for (int rep0 = 0; rep0 < REP_P0; ++rep0) {
    for (int it = blk; it < 48 + NG; it += G) {
        TIDS();
        if (it < 48) {
            LAS float* sil = (LAS float*)(lds + wave * 16384);
            LAS float* red = (LAS float*)(lds + wave * 16384 + 8192);
            for (int idx = lane; idx < 2048; idx += 64) { const int kk = idx >> 4, b = idx & 15, k = wave * 128 + kk;
                const float c = (b < 8) ? P.c_prompt[b * DM + k] : P.c_sample[(b - 8) * DM + k]; sil[idx] = siluf_(c); }
            asm volatile("s_waitcnt lgkmcnt(0)" ::: "memory");
            const int col = it * 64 + lane;
            float acc[16];
#pragma unroll
            for (int b = 0; b < 16; ++b) acc[b] = 0.f;
#pragma unroll 32
            for (int kk = 0; kk < 128; ++kk) { const float wv = P.w_ada[(size_t)(wave * 128 + kk) * 3072 + col];
#pragma unroll
                for (int q = 0; q < 4; ++q) { const f32x4 s = *(const LAS f32x4*)(sil + kk * 16 + 4 * q); acc[4 * q] += s[0] * wv; acc[4 * q + 1] += s[1] * wv; acc[4 * q + 2] += s[2] * wv; acc[4 * q + 3] += s[3] * wv; } }
#pragma unroll
            for (int b = 0; b < 16; ++b) red[b * 64 + lane] = acc[b];
            __syncthreads();
#pragma unroll
            for (int bb = 0; bb < 2; ++bb) { const int b = wave * 2 + bb; float s = P.b_ada[col];
#pragma unroll
                for (int w = 0; w < 8; ++w) s += *((LAS float*)(lds + w * 16384 + 8192) + b * 64 + lane);
                MOD[b * 3072 + col] = s; }
            __syncthreads();
        } else {
            const int g = it - 48;
            LAS f32x2* PW = (LAS f32x2*)lds;
            LAS f32x2* BBl = (LAS f32x2*)(lds + 8704);
            LAS f32x2* CCl = (LAS f32x2*)(lds + 16896);
            LAS float* KT = (LAS float*)(lds + 25088);
            if (tid < 64) { const int n = tid; const float dt = expf(P.log_dt[g]); const float are = P.a_re[g * 64 + n], aim = P.a_im[g * 64 + n];
                const float mag = expf(are * dt), ang = aim * dt; float sn, cs; sincosf(ang, &sn, &cs);
                const f32x2 ab = {mag * cs, mag * sn};
                const float den = are * are + aim * aim, nre = ab.x - 1.f, nim = ab.y;
                const f32x2 q = {(nre * are + nim * aim) / den, (nim * are - nre * aim) / den};
                f32x2 pw = {1.f, 0.f};
                for (int j = 0; j <= 16; ++j) { PW[j * 64 + n] = pw; pw = cmul(pw, ab); }
                ABAR[g * 64 + n] = ab; A16[g * 64 + n] = PW[16 * 64 + n];
                f32x4 brv[4], biv[4];
#pragma unroll
                for (int p4 = 0; p4 < 4; ++p4) { brv[p4] = *(const f32x4*)(P.b_re + (g * 64 + n) * 16 + 4 * p4); biv[p4] = *(const f32x4*)(P.b_im + (g * 64 + n) * 16 + 4 * p4); }
#pragma unroll
                for (int p = 0; p < 16; ++p) { const f32x2 bb = {brv[p >> 2][p & 3], biv[p >> 2][p & 3]}; const f32x2 v = cmul(q, bb); BBl[n * 16 + p] = v; BBAR[(g * 64 + n) * 16 + p] = v; } }
            for (int idx = tid; idx < 1024; idx += NTHR) CCl[idx] = (f32x2){P.c_re[g * 1024 + idx], P.c_im[g * 1024 + idx]};
            __syncthreads();
            for (int idx = tid; idx < 4096; idx += NTHR) { const int d = idx >> 8, p = (idx >> 4) & 15, pp = idx & 15; float s = 0.f;
                for (int n = 0; n < 64; ++n) { const f32x2 t = cmul(CCl[p * 64 + n], PW[d * 64 + n]); const f32x2 b = BBl[n * 16 + pp]; s += t.x * b.x - t.y * b.y; }
                if (d == 0 && p == pp) s += P.d_skip[g * 16 + p];
                KT[idx] = s; }
            __syncthreads();
            bf16_t* w2 = W2 + (size_t)g * 256 * 384;
            for (int idx = tid; idx < 256 * 192; idx += NTHR) { const int c = idx / 192, k = (idx % 192) * 2, t = c >> 4, p = c & 15; float v[2];
#pragma unroll
                for (int e = 0; e < 2; ++e) { const int kk = k + e; float r;
                    if (kk < 256) { const int s = kk >> 4, pp = kk & 15; r = (s <= t) ? KT[((t - s) * 16 + p) * 16 + pp] : 0.f; }
                    else { const int n = (kk - 256) & 63; const f32x2 z = cmul(CCl[p * 64 + n], PW[(t + 1) * 64 + n]); r = (kk < 320) ? z.x : -z.y; }
                    v[e] = r; }
                *(unsigned*)(w2 + (size_t)c * 384 + k) = pk2(v[0], v[1]); }
            bf16_t* w1 = W1 + (size_t)g * 256 * 256;
            for (int idx = tid; idx < 256 * 128; idx += NTHR) { const int np = idx >> 7, k = (idx & 127) * 2; float v[2];
#pragma unroll
                for (int e = 0; e < 2; ++e) { const int kk = k + e, s = kk >> 4, pp = kk & 15; float r = 0.f;
                    if (np < 128) { const int n = np & 63; const f32x2 z = cmul(PW[(15 - s) * 64 + n], BBl[n * 16 + pp]); r = (np < 64) ? z.x : z.y; }
                    v[e] = r; }
                *(unsigned*)(w1 + (size_t)np * 256 + k) = pk2(v[0], v[1]); }
            __syncthreads();
        }
    }
    {
        TIDS();
        LAS float* scr = (LAS float*)(lds + wave * 16384);
        const bool spare = G > 2 * (48 + NG);
        const int bq = spare ? blk - (48 + NG) : blk, Gq = spare ? G - (48 + NG) : G;
        const int gw = bq * NWAVES + wave, NGW = Gq * NWAVES;
        constexpr int I_IN = (DM / 64) * (NPROJ / 32), I_GLU = (SW / 64) * (SW / 32), I_OUT = (DM / 64) * (DM / 32);
        for (int it = (bq >= 0 ? gw : 0x7fffffff - NGW); it < I_IN + I_GLU + I_OUT; it += NGW) {
            int r = it;
            if (r < I_IN) { p0_transpose_item<true>(P.w_in, DM, NPROJ, INW, WIN, scr, r, lane); continue; } r -= I_IN;
            if (r < I_GLU) { p0_transpose_item<false>(P.w_glu, SW, SW, SW, WGLU, scr, r, lane); continue; } r -= I_GLU;
            p0_transpose_item<false>(P.w_out, DM, DM, DM, WOUT, scr, r, lane);
        }
        const int gt = (bq >= 0) ? bq * NTHR + tid : 0x7fffffff - Gq * NTHR, NGT = Gq * NTHR;
#pragma unroll 4
        for (int i = gt; i < NB * PAST * 64; i += NGT) { const int row = i >> 6, ch = i & 63, b = row >> 11, j = row & 2047;
            const f32x4 k0 = *(const f32x4*)(P.cache_k + (size_t)row * 512 + ch * 8), k1 = *(const f32x4*)(P.cache_k + (size_t)row * 512 + ch * 8 + 4);
            const f32x4 v0 = *(const f32x4*)(P.cache_v + (size_t)row * 512 + ch * 8), v1 = *(const f32x4*)(P.cache_v + (size_t)row * 512 + ch * 8 + 4);
            *(u32x4*)(KS + (size_t)(b * SKV + j) * 512 + ch * 8) = (u32x4){pk2(k0[0], k0[1]), pk2(k0[2], k0[3]), pk2(k1[0], k1[1]), pk2(k1[2], k1[3])};
            *(u32x4*)(VS + (size_t)(b * SKV + j) * 512 + ch * 8) = (u32x4){pk2(v0[0], v0[1]), pk2(v0[2], v0[3]), pk2(v1[0], v1[1]), pk2(v1[2], v1[3])}; }
        for (int i = gt; i < NB * PAST * NH; i += NGT) { const int b = i / (PAST * NH), r = i % (PAST * NH); LFS[(size_t)b * SKV * NH + r] = P.cache_logf[i]; }
    }
    }
    if (G == 0x7fffffff) grid.sync();
    GRID_BAR();

    for (int rep = 0; rep < REP_P1; ++rep) {
        TIDS();
        __syncthreads();
        LAS float* w8 = (LAS float*)lds;
#pragma unroll
        for (int i0 = 0; i0 < 8192; i0 += NTHR) { const int i = i0 + tid, c = i >> 10, k = i & 1023; w8[i] = P.w_in[(size_t)k * INW + NPROJ + c]; }
        __syncthreads();
        const int gw = blk * NWAVES + wave, NGW = G * NWAVES;
        constexpr int NPAIR = MT / 2; const int per = (NPAIR + NGW - 1) / NGW;
        const int p_lo = gw * per, p_hi = (p_lo + per < NPAIR) ? p_lo + per : NPAIR;
        int cur_b = -1; f32x4 Ak[4], Bk[4]; float bsel = 0.f;
        for (int j = 0; j < 4; ++j) { Ak[j] = (f32x4){0.f, 0.f, 0.f, 0.f}; Bk[j] = Ak[j]; }
        f32x4 x0[4], x1[4];
        auto rowptr = [&](int m) -> const float* { return (m < PT) ? P.x_prompt + (size_t)m * DM : P.x_sample + (size_t)(m - PT) * DM; };
        if (p_lo < p_hi) { const float* r0 = rowptr(2 * p_lo); const float* r1 = rowptr(2 * p_lo + 1);
#pragma unroll
            for (int j = 0; j < 4; ++j) { x0[j] = __builtin_nontemporal_load((const f32x4*)r0 + lane + 64 * j); x1[j] = __builtin_nontemporal_load((const f32x4*)r1 + lane + 64 * j); } }
        for (int p = p_lo; p < p_hi; ++p) {
            const int m0 = 2 * p;
            const int bidx = (m0 < PT) ? (m0 >> 13) : 8 + ((m0 - PT) >> 6);
            if (bidx != cur_b) {
                cur_b = bidx; const float* md = MOD + (size_t)bidx * 3072; float b2[8];
#pragma unroll
                for (int c = 0; c < 8; ++c) b2[c] = 0.f;
#pragma unroll
                for (int j = 0; j < 4; ++j) { const int k = 4 * lane + 256 * j;
                    const f32x4 gv = *(const f32x4*)(P.norm_g + k), sh = *(const f32x4*)(md + k), sc = *(const f32x4*)(md + 1024 + k);
                    Ak[j] = gv * (sc + 1.f); Bk[j] = sh;
#pragma unroll
                    for (int c = 0; c < 8; ++c) { const f32x4 w = *(const LAS f32x4*)(w8 + c * 1024 + k); b2[c] += (sh.x * w.x + sh.y * w.y) + (sh.z * w.z + sh.w * w.w); } }
#pragma unroll
                for (int c = 0; c < 8; ++c) b2[c] = wave_sum(b2[c]);
                bsel = b2[0];
#pragma unroll
                for (int c = 1; c < 8; ++c) bsel = (((lane >> 2) & 7) == c) ? b2[c] : bsel;
                bsel += P.b_f[(lane >> 2) & 7];
            }
            f32x4 n0[4], n1[4];
            { const int pn = (p + 1 < p_hi) ? p + 1 : p; const float* r0 = rowptr(2 * pn); const float* r1 = rowptr(2 * pn + 1);
#pragma unroll
              for (int j = 0; j < 4; ++j) { n0[j] = __builtin_nontemporal_load((const f32x4*)r0 + lane + 64 * j); n1[j] = __builtin_nontemporal_load((const f32x4*)r1 + lane + 64 * j); } }
            float ss0 = 0.f, ss1 = 0.f, v[16];
#pragma unroll
            for (int c = 0; c < 16; ++c) v[c] = 0.f;
#pragma unroll
            for (int j = 0; j < 4; ++j) { const int k = 4 * lane + 256 * j;
                ss0 += (x0[j].x * x0[j].x + x0[j].y * x0[j].y) + (x0[j].z * x0[j].z + x0[j].w * x0[j].w);
                ss1 += (x1[j].x * x1[j].x + x1[j].y * x1[j].y) + (x1[j].z * x1[j].z + x1[j].w * x1[j].w);
                x0[j] = x0[j] * Ak[j]; x1[j] = x1[j] * Ak[j];
#pragma unroll
                for (int c = 0; c < 8; ++c) { const f32x4 w = *(const LAS f32x4*)(w8 + c * 1024 + k);
                    v[c] += (x0[j].x * w.x + x0[j].y * w.y) + (x0[j].z * w.z + x0[j].w * w.w);
                    v[8 + c] += (x1[j].x * w.x + x1[j].y * w.y) + (x1[j].z * w.z + x1[j].w * w.w); }
                asm volatile("" ::: "memory"); }
            ss0 = wave_sum(ss0); ss1 = wave_sum(ss1);
#define P1_STEP(nn, mask) _Pragma("unroll") for (int i = 0; i < nn; ++i) { const bool up = (lane & mask) != 0; const float keep = up ? v[i + nn] : v[i], send = up ? v[i] : v[i + nn]; v[i] = keep + __shfl_xor(send, mask); }
            P1_STEP(8, 32) P1_STEP(4, 16) P1_STEP(2, 8) P1_STEP(1, 4)
#undef P1_STEP
            v[0] += __shfl_xor(v[0], 2); v[0] += __shfl_xor(v[0], 1);
            const float rs0 = rsqrtf(ss0 * (1.f / DM) + NORM_EPS), rs1 = rsqrtf(ss1 * (1.f / DM) + NORM_EPS);
#pragma unroll
            for (int j = 0; j < 4; ++j) { const f32x4 h0 = x0[j] * rs0 + Bk[j], h1 = x1[j] * rs1 + Bk[j];
                *((u32x2*)(XN + (size_t)m0 * DM) + lane + 64 * j) = (u32x2){pk2(h0.x, h0.y), pk2(h0.z, h0.w)};
                *((u32x2*)(XN + (size_t)(m0 + 1) * DM) + lane + 64 * j) = (u32x2){pk2(h1.x, h1.y), pk2(h1.z, h1.w)}; }
            if ((lane & 3) == 0) { const int r = lane >> 5, c = (lane >> 2) & 7, m = m0 + r;
                const float z = (r ? rs1 : rs0) * v[0] + bsel; const float lf = fminf(z, 0.f) - log1pf(__expf(-fabsf(z)));
                if (m < PT) out[O_LFP + (size_t)m * NH + c] = lf;
                else { const int sidx = m - PT, b = sidx >> 6, t = sidx & 63; out[O_LFS + (size_t)sidx * NH + c] = lf; LFS[(size_t)(b * SKV + PAST + t) * NH + c] = lf; } }
#pragma unroll
            for (int j = 0; j < 4; ++j) { x0[j] = n0[j]; x1[j] = n1[j]; }
        }
    }
    GRID_BAR();

    for (int rep = 0; rep < REP_P2; ++rep) {
        for (int it = blk; it < 256; it += G) {
            const int mb = it & 15, ns = it >> 4;
            LAS float* Cs = (LAS float*)lds; constexpr int ldc = 196;
            __syncthreads();
            skinny32(Cs, XN + (size_t)(PT + 32 * mb) * DM, DM, WIN, DM, 192, DM,
                     [&](int ct) { const int n = 192 * ns + 16 * ct, o = n & 255; return (n & ~255) + 128 * ((o >> 5) & 1) + 32 * (o >> 6) + (o & 31); });
            const int tid = fresh_tid();
#pragma unroll
            for (int ps = 0; ps < 2; ++ps) {
                const int task = tid + 512 * ps; const bool ok = task < 768; const int tk = ok ? task : 0;
                const int row = tk / 24, ch = tk % 24, n = 192 * ns + 8 * ch, type = n >> 9, cb = n & 511, d0 = n & 63;
                const f32x4 c0 = *(const LAS f32x4*)(Cs + row * ldc + 8 * ch), c1 = *(const LAS f32x4*)(Cs + row * ldc + 8 * ch + 4);
                float v[8] = {c0[0], c0[1], c0[2], c0[3], c1[0], c1[1], c1[2], c1[3]};
                float ss = 0.f;
#pragma unroll
                for (int e = 0; e < 8; ++e) ss += v[e] * v[e];
                ss += __shfl_xor(ss, 1); ss += __shfl_xor(ss, 2); ss += __shfl_xor(ss, 4);
                if (ok) {
                    const int sidx = 32 * mb + row, m = PT + sidx, b = sidx >> 6, t = sidx & 63;
                    if (type == 2 || type == 3) { const float rs = rsqrtf(ss * (1.f / 64.f) + NORM_EPS); const float* gp = (type == 2) ? P.q_g : P.k_g;
#pragma unroll
                        for (int e = 0; e < 8; ++e) v[e] = v[e] * rs * gp[d0 + e] * (type == 2 ? C2 : 1.f); }
                    else if (type == 1 || type == 5) {
#pragma unroll
                        for (int e = 0; e < 8; ++e) v[e] = siluf_(v[e]); }
                    bf16_t* bdst; float* fdst = nullptr;
                    if (type == 0) bdst = UX + ux_off(m, cb);
                    else if (type == 1) bdst = ZS + (size_t)m * 512;
                    else if (type == 2) bdst = QB + (size_t)m * 512;
                    else if (type == 5) bdst = ZA + (size_t)m * 512;
                    else { bdst = (type == 3 ? KS : VS) + (size_t)(b * SKV + PAST + t) * 512; fdst = out + (type == 3 ? O_KS : O_VS) + (size_t)sidx * 512; }
                    *(u32x4*)(bdst + (type == 0 ? 0 : cb)) = (u32x4){pk2(v[0], v[1]), pk2(v[2], v[3]), pk2(v[4], v[5]), pk2(v[6], v[7])};
                    if (fdst) { *(f32x4*)(fdst + cb) = (f32x4){v[0], v[1], v[2], v[3]}; *(f32x4*)(fdst + cb + 4) = (f32x4){v[4], v[5], v[6], v[7]}; }
                }
            }
            __syncthreads();
        }
        pg8::Gemm g{DM * 2, DM * 2, 128, 128, DM / 64, 0}; pg8::StaticOrder S; S.init(PT, NPROJ, G, blk, XN, WIN, DM * 2, DM * 2);
        EpiInProj E{UX, ZS, QB, ZA, KB, VB, KS, VS, out + O_KP, out + O_VP, out + O_KS, out + O_VS, P.q_g, P.k_g};
        pg8::gemm_phase<EpiInProj, pg8::StaticOrder>(lds, g, S, E);
    }
    GRID_BAR();

    for (int rep3 = 0; rep3 < REP_P3; ++rep3) {
    __syncthreads();
    {
        pg8::Gemm g{UXR * 32, 256 * 2, 128, 128, 4, 0}; pg8::S5Order S{G, blk, (const char*)UX, (const char*)W1, (size_t)256 * 256 * 2};
        EpiS E{SB};
        pg8::gemm_phase<EpiS, pg8::S5Order>(lds, g, S, E);
    }
    __syncthreads();
    for (int it = blk; it < NB * NG; it += G) {
        TIDS();
        const int b = it >> 5, g = it & 31;
        LAS f32x2* XS = (LAS f32x2*)lds;
        LAS float* US = (LAS float*)(lds + 33280);
        LAS float* CR = (LAS float*)(lds + 37376);
        LAS float* CI = (LAS float*)(lds + 41536);
        for (int i = tid; i < 1024; i += NTHR) { const int t = i >> 4, p = i & 15, s = b * 64 + t; US[i] = bf2f(UX[ux_off(PT + s, g * 16 + p)]);
            CR[(i >> 6) * 65 + (i & 63)] = P.c_re[g * 1024 + i]; CI[(i >> 6) * 65 + (i & 63)] = P.c_im[g * 1024 + i]; }
        __syncthreads();
        { const int n = lane; f32x2 bb[16];
#pragma unroll
          for (int p = 0; p < 16; ++p) bb[p] = BBAR[(g * 64 + n) * 16 + p];
#pragma unroll
          for (int tt = 0; tt < 8; ++tt) { const int t = wave * 8 + tt; f32x2 bu = {0.f, 0.f};
#pragma unroll
              for (int p = 0; p < 16; ++p) { const float uu = US[t * 16 + p]; bu.x += bb[p].x * uu; bu.y += bb[p].y * uu; }
              XS[t * 65 + n] = bu; } }
        __syncthreads();
        if (wave == 0) { const int n = lane; f32x2 xst = {P.st_re[(b * NG + g) * 64 + n], P.st_im[(b * NG + g) * 64 + n]}; const f32x2 ab = ABAR[g * 64 + n];
#pragma unroll 8
            for (int t = 0; t < 64; ++t) { const f32x2 bu = XS[t * 65 + n]; const f32x2 ax = cmul(ab, xst); xst = (f32x2){ax.x + bu.x, ax.y + bu.y}; XS[t * 65 + n] = xst; }
            out[O_RS + (b * NG + g) * 64 + n] = xst.x; out[O_IS + (b * NG + g) * 64 + n] = xst.y; }
        __syncthreads();
        { const int t = tid >> 3, pp = tid & 7;
#pragma unroll
          for (int e = 0; e < 2; ++e) { const int p = pp + 8 * e; float y = P.d_skip[g * 16 + p] * US[t * 16 + p];
#pragma unroll 8
              for (int n = 0; n < 64; ++n) { const f32x2 xv = XS[t * 65 + n]; y += CR[p * 65 + n] * xv.x - CI[p * 65 + n] * xv.y; }
              YSS[(size_t)(b * 64 + t) * 512 + g * 16 + p] = (bf16_t)f2bf(gelu_tanh(y)); } }
        __syncthreads();
    }
    }
    GRID_BAR();

    for (int it = blk; it < 128; it += G) {
        const int mb = it & 15, ns = it >> 4;
        LAS float* Cs = (LAS float*)lds; constexpr int ldc = 68;
        __syncthreads();
        skinny32(Cs, YSS + (size_t)(32 * mb) * SW, SW, WGLU, SW, 64, SW, [&](int ct) { return 64 * ns + 16 * ct; });
        const int tid = fresh_tid();
        if (tid < 256) { const int row = tid >> 3, ch = tid & 7, col = 64 * ns + 8 * ch, m = PT + 32 * mb + row;
            const f32x4 c0 = *(const LAS f32x4*)(Cs + row * ldc + 8 * ch) + *(const f32x4*)(P.b_glu + col), c1 = *(const LAS f32x4*)(Cs + row * ldc + 8 * ch + 4) + *(const f32x4*)(P.b_glu + col + 4);
            const u32x4 ys = *(const u32x4*)(YSS + (size_t)(m - PT) * 512 + col), zs = *(const u32x4*)(ZS + (size_t)m * 512 + col);
            u32x4 w;
            w.x = pk2(bflo(ys.x) * sigmoidf_(c0[0]) * bflo(zs.x), bfhi(ys.x) * sigmoidf_(c0[1]) * bfhi(zs.x));
            w.y = pk2(bflo(ys.y) * sigmoidf_(c0[2]) * bflo(zs.y), bfhi(ys.y) * sigmoidf_(c0[3]) * bfhi(zs.y));
            w.z = pk2(bflo(ys.z) * sigmoidf_(c1[0]) * bflo(zs.z), bfhi(ys.z) * sigmoidf_(c1[1]) * bfhi(zs.z));
            w.w = pk2(bflo(ys.w) * sigmoidf_(c1[2]) * bflo(zs.w), bfhi(ys.w) * sigmoidf_(c1[3]) * bfhi(zs.w));
            *(u32x4*)(MX + (size_t)m * 1024 + col) = w; }
        __syncthreads();
    }
    for (int repc = 0; repc < REP_CH; ++repc) {
    for (int it = blk; it < NB * NG; it += G) {
        TIDS();
        const int b = it >> 5, g = it & 31, n = lane, w = wave;
        LAS f32x2* EE = (LAS f32x2*)lds;
        const f32x2 a16 = A16[g * 64 + n];
        const float* sp = SB + ((size_t)g * NCH + b * 512 + w * 64) * 128;
        f32x2 e = {0.f, 0.f};
#pragma unroll 32
        for (int c = 0; c < 64; ++c) { const f32x2 s = {sp[c * 128 + n], sp[c * 128 + 64 + n]}; const f32x2 ax = cmul(a16, e); e = (f32x2){ax.x + s.x, ax.y + s.y}; }
        EE[w * 64 + n] = e;
        __syncthreads();
        f32x2 a64 = a16;
#pragma unroll
        for (int i = 0; i < 6; ++i) a64 = cmul(a64, a64);
        f32x2 h = {0.f, 0.f};
        for (int ww = 0; ww < w; ++ww) { const f32x2 ax = cmul(a64, h); const f32x2 ev = EE[ww * 64 + n]; h = (f32x2){ax.x + ev.x, ax.y + ev.y}; }
        bf16_t* ux = UX + ((size_t)g * UXROWS + b * 512 + w * 64) * (UXR * 16);
#pragma unroll 32
        for (int c = 0; c < 64; ++c) {
            ux[(c * UXR + 16) * 16 + n] = (bf16_t)f2bf(h.x); ux[(c * UXR + 20) * 16 + n] = (bf16_t)f2bf(h.y);
            const f32x2 s = {sp[c * 128 + n], sp[c * 128 + 64 + n]}; const f32x2 ax = cmul(a16, h); h = (f32x2){ax.x + s.x, ax.y + s.y}; }
        if (w == 7) { out[O_RP + (b * NG + g) * 64 + n] = h.x; out[O_IP + (b * NG + g) * 64 + n] = h.y; }
        __syncthreads();
    }
    }
    for (int rep = 0; rep < REP_ATT; ++rep) {
        TIDS();
        float gqm = fabsf(P.q_g[lane]), gkm = fabsf(P.k_g[lane]);
#pragma unroll
        for (int o = 1; o < 64; o <<= 1) { gqm = fmaxf(gqm, __shfl_xor(gqm, o)); gkm = fmaxf(gkm, __shfl_xor(gkm, o)); }
        const float qkmax = 64.f * gqm * gkm * C2 * 1.02f + 0.25f, thresh = 37.f + 2.f * qkmax;
        LAS unsigned* uw = (LAS unsigned*)(lds + att::LDS_UNIT);
        constexpr int NUNITS = 64 + NB * NH * (SEQ / 256);
        unsigned nxt_ui = 0u;
        if (tid == 0) nxt_ui = atomicAdd(CTL + 64 + 64 * rep, 1u);
        for (;;) {
            asm volatile("s_waitcnt lgkmcnt(0)\n\ts_barrier" ::: "memory");
            if (tid == 0) { uw[0] = nxt_ui; nxt_ui = atomicAdd(CTL + 64 + 64 * rep, 1u); }
            asm volatile("s_waitcnt lgkmcnt(0)\n\ts_barrier" ::: "memory");
            const int ui = __builtin_amdgcn_readfirstlane((int)uw[0]);
            if (ui >= NUNITS) break;
            att::UnitDesc u;
            if (ui < 64) { const int b = ui >> 3, h = ui & 7;
                u.Q = QB + (size_t)(PT + b * 64) * 512 + h * 64; u.K = KS + (size_t)b * SKV * 512 + h * 64; u.V = VS + (size_t)b * SKV * 512 + h * 64; u.LF = LFS + (size_t)b * SKV * NH + h;
                u.Zg = ZA + (size_t)(PT + b * 64) * 512 + h * 64; u.O = MX + (size_t)(PT + b * 64) * 1024 + 512 + h * 64; u.q0 = PAST; u.nq = 64; }
            else { const int r = ui - 64, qb = 31 - (r >> 6), bh = r & 63, b = bh >> 3, h = bh & 7; const size_t row0 = (size_t)b * SEQ + qb * 256;
                u.Q = QB + row0 * 512 + h * 64; u.K = KB + (size_t)b * SEQ * 512 + h * 64; u.V = VB + (size_t)b * SEQ * 512 + h * 64; u.LF = out + O_LFP + (size_t)b * SEQ * NH + h;
                u.Zg = ZA + row0 * 512 + h * 64; u.O = MX + row0 * 1024 + 512 + h * 64; u.q0 = qb * 256; u.nq = 256; }
            att::attn_unit(u, lds, qkmax, thresh);
        }
    }
    GRID_BAR();

    for (int it = blk; it < 256; it += G) {
        const int mb = it & 15, ns = it >> 4;
        LAS float* Cs = (LAS float*)lds; constexpr int ldc = 68;
        __syncthreads();
        skinny32(Cs, MX + (size_t)(PT + 32 * mb) * DM, DM, WOUT, DM, 64, DM, [&](int ct) { return 64 * ns + 16 * ct; });
        const int tid = fresh_tid();
        if (tid < 256) { const int row = tid >> 3, ch = tid & 7, col = 64 * ns + 8 * ch, sidx = 32 * mb + row; const float* gt = MOD + (size_t)(8 + (sidx >> 6)) * 3072 + 2048 + col;
            const float* xr = P.x_sample + (size_t)sidx * DM + col; float* yr = out + O_YS + (size_t)sidx * DM + col;
            *(f32x4*)yr = *(const f32x4*)xr + *(const f32x4*)gt * *(const LAS f32x4*)(Cs + row * ldc + 8 * ch);
            *(f32x4*)(yr + 4) = *(const f32x4*)(xr + 4) + *(const f32x4*)(gt + 4) * *(const LAS f32x4*)(Cs + row * ldc + 8 * ch + 4); }
        __syncthreads();
    }
    for (int rep5 = 0; rep5 < REP_P5; ++rep5) {
        pg8::Gemm g{UXR * 32, 384 * 2, 128, 128, 6, 0}; pg8::S5Order S{G, blk, (const char*)UX, (const char*)W2, (size_t)256 * 384 * 2};
        EpiY E{YS};
        pg8::gemm_phase<EpiY, pg8::S5Order>(lds, g, S, E);
    }
    GRID_BAR();

    for (int rep6 = 0; rep6 < REP_P6; ++rep6) {
        pg8::Gemm g{32, SW * 2, (size_t)4 * PT * 32, 128, SW / 64, (unsigned)(PT * 32)}; pg8::StaticOrder S; S.init(PT, SW, G, blk, YS, WGLU, 32, SW * 2);
        EpiGlu E{YS, ZS, P.b_glu, MX};
        pg8::gemm_phase<EpiGlu, pg8::StaticOrder>(lds, g, S, E);
    }
    GRID_BAR();

    for (int rep = 0; rep < REP_P7; ++rep) {
        pg8::Gemm g{DM * 2, DM * 2, 128, 128, DM / 64, 0}; pg8::StaticOrder S; S.init(PT, DM, G, blk, MX, WOUT, DM * 2, DM * 2);
        EpiOut E{P.x_prompt, P.x_sample, MOD, out + O_YP, out + O_YS};
        pg8::gemm_phase<EpiOut, pg8::StaticOrder>(lds, g, S, E);
    }
    for (int i = 0; i < EXTRA_SYNCS; ++i) GRID_BAR();
}

extern "C" void kernel_launch(void* const* d_in, const int* in_sizes, int n_in, void* d_out, int out_size, void* d_ws, size_t ws_size, hipStream_t stream) {
    static int grid = 0;
    if (grid == 0) {
        if (n_in != 27 || (size_t)out_size != O_END || ws_size < WS_END) { fprintf(stderr, "kernel_launch: unexpected shapes: n_in %d out %d ws %zu\n", n_in, out_size, ws_size); grid = -1; return; }
        int dev = 0, cus = 0, per_cu = 0;
        if (hipGetDevice(&dev) != hipSuccess || hipDeviceGetAttribute(&cus, hipDeviceAttributeMultiprocessorCount, dev) != hipSuccess) { grid = -1; return; }
        if (hipFuncSetAttribute((const void*)hymba_fwd, hipFuncAttributeMaxDynamicSharedMemorySize, LDS_BYTES) != hipSuccess) { fprintf(stderr, "kernel_launch: hipFuncSetAttribute failed\n"); grid = -1; return; }
        if (hipOccupancyMaxActiveBlocksPerMultiprocessor(&per_cu, (const void*)hymba_fwd, NTHR, LDS_BYTES) != hipSuccess || per_cu < 1) { fprintf(stderr, "kernel_launch: occupancy query gives %d\n", per_cu); (void)hipGetLastError(); grid = -1; return; }
        grid = cus;
    }
    if (grid < 0) return;
    (void)hipMemsetAsync((char*)d_ws + WS_CTL, 0, CTL_BYTES, stream);
    Params p{};
    const float** pp = (const float**)&p;
    for (int i = 0; i < 27; ++i) pp[i] = (const float*)d_in[i];
    p.out = (float*)d_out; p.ws = (unsigned char*)d_ws;
    void* args[] = {&p};
    hipError_t e = hipLaunchCooperativeKernel((const void*)hymba_fwd, dim3(grid), dim3(NTHR), args, LDS_BYTES, stream);
    if (e != hipSuccess) fprintf(stderr, "kernel_launch: cooperative launch failed: %s (grid %d)\n", hipGetErrorString(e), grid);
}
```
